# Optimizing an MI355X kernel written in HIP

```python
import jax, jax.numpy as jnp
from jax import lax
import numpy as np

D_MODEL = 1024
BATCH = 2
SEQ = 8192
DEPTH = 2

GRID_W = 64

N_FOURIER_GROUPS = 4
FOURIER_GROUP_DIM = 128
D_FOURIER = N_FOURIER_GROUPS * FOURIER_GROUP_DIM

N_Q_HEADS = 8
N_KV_HEADS = 2
HEAD_DIM = 64
D_ATTN = N_Q_HEADS * HEAD_DIM
D_KV = N_KV_HEADS * HEAD_DIM
ROPE_AXIS_DIM = HEAD_DIM // 2
ROPE_THETA = 10000.0
Q_BLOCK = 128

D_GATE = D_MODEL
SPLITS = [D_FOURIER,
          D_FOURIER + D_ATTN,
          D_FOURIER + D_ATTN + D_KV,
          D_FOURIER + D_ATTN + 2 * D_KV,
          D_FOURIER + D_ATTN + 2 * D_KV + D_GATE]
D_IN_PROJ = D_FOURIER + D_ATTN + 2 * D_KV + 2 * D_GATE

PEER_HEADS = 8
PEER_N_KEYS = 128
PEER_N_EXPERTS = PEER_N_KEYS * PEER_N_KEYS
PEER_TOPK = 16
PEER_QUERY_DIM = 256
PEER_HALF = PEER_QUERY_DIM // 2
PEER_TOKEN_BLOCK = 128

DEEPNORM_ALPHA = (2.0 * DEPTH) ** 0.25
DEEPNORM_BETA = (8.0 * DEPTH) ** -0.25

LN_EPS = 1e-5
RMS_EPS = 1e-6

kernel_name = "hybrid_fnet_gqa_peer_deepnorm_encoder"


def layer_norm(x, g, b):
    xf = x.astype(jnp.float32)
    mu = jnp.mean(xf, axis=-1, keepdims=True)
    xc = xf - mu
    var = jnp.mean(xc * xc, axis=-1, keepdims=True)
    return (xc * lax.rsqrt(var + LN_EPS) * g + b).astype(x.dtype)


def rms_norm(x, g):
    xf = x.astype(jnp.float32)
    ms = jnp.mean(xf * xf, axis=-1, keepdims=True)
    return (xf * lax.rsqrt(ms + RMS_EPS) * g).astype(x.dtype)


def axial_rope_tables(seq_len, dtype):
    rows = seq_len // GRID_W
    row_id = jnp.repeat(jnp.arange(rows, dtype=jnp.float32), GRID_W)
    col_id = jnp.tile(jnp.arange(GRID_W, dtype=jnp.float32), rows)
    inv_freq = 1.0 / (ROPE_THETA ** (jnp.arange(0, ROPE_AXIS_DIM, 2, dtype=jnp.float32) / ROPE_AXIS_DIM))
    ang_r = row_id[:, None] * inv_freq[None, :]
    ang_c = col_id[:, None] * inv_freq[None, :]
    ang = jnp.concatenate([ang_r, ang_r, ang_c, ang_c], axis=-1)
    return jnp.cos(ang).astype(dtype), jnp.sin(ang).astype(dtype)


def apply_axial_rope(x, cos, sin):
    xr = x.reshape(*x.shape[:-1], 2, 2, ROPE_AXIS_DIM // 2)
    rot = jnp.concatenate([-xr[..., 1:2, :], xr[..., 0:1, :]], axis=-2).reshape(x.shape)
    return x * cos[None, :, None, :] + rot * sin[None, :, None, :]


def fourier_mix(xf):
    b, s, _ = xf.shape
    xg = xf.reshape(b, s, N_FOURIER_GROUPS, FOURIER_GROUP_DIM).astype(jnp.float32)
    y = jnp.fft.fft2(xg, axes=(1, 3), norm="ortho").real
    return y.reshape(b, s, D_FOURIER).astype(xf.dtype)


def block_attention(q, k, v):
    b, s = q.shape[:2]
    nblk = s // Q_BLOCK
    grp = N_Q_HEADS // N_KV_HEADS
    qb = q.reshape(b, nblk, Q_BLOCK, N_KV_HEADS, grp, HEAD_DIM).transpose(1, 0, 3, 4, 2, 5)
    kt = k.transpose(0, 2, 1, 3)
    vt = v.transpose(0, 2, 1, 3)
    scale = HEAD_DIM ** -0.5

    def one_block(qblk):
        sc = jnp.einsum('bkgqd,bksd->bkgqs', qblk, kt).astype(jnp.float32) * scale
        p = jax.nn.softmax(sc, axis=-1)
        return jnp.einsum('bkgqs,bksd->bkgqd', p.astype(vt.dtype), vt)

    o = lax.map(one_block, qb)
    return o.transpose(1, 0, 4, 2, 3, 5).reshape(b, s, D_ATTN)


def peer_ffn(x, w_query, sub_keys, u_tab, v_tab):
    b, s, d = x.shape
    xt = x.reshape((b * s) // PEER_TOKEN_BLOCK, PEER_TOKEN_BLOCK, d)

    def one_block(xc):
        q = (xc @ w_query).reshape(-1, PEER_HEADS, 2, PEER_HALF)
        s1 = jnp.einsum('thd,hkd->thk', q[:, :, 0], sub_keys[:, 0]).astype(jnp.float32)
        s2 = jnp.einsum('thd,hkd->thk', q[:, :, 1], sub_keys[:, 1]).astype(jnp.float32)
        v1, i1 = lax.top_k(s1, PEER_TOPK)
        v2, i2 = lax.top_k(s2, PEER_TOPK)
        cand = (v1[..., :, None] + v2[..., None, :]).reshape(*v1.shape[:-1], PEER_TOPK * PEER_TOPK)
        cidx = (i1[..., :, None] * PEER_N_KEYS + i2[..., None, :]).reshape(*i1.shape[:-1], PEER_TOPK * PEER_TOPK)
        sv, pos = lax.top_k(cand, PEER_TOPK)
        eidx = jnp.take_along_axis(cidx, pos, axis=-1)
        gate = jax.nn.softmax(sv, axis=-1)
        u = u_tab[eidx]
        act = jax.nn.gelu(jnp.einsum('thkd,td->thk', u, xc), approximate=False)
        w = gate.astype(act.dtype) * act
        vv = v_tab[eidx]
        return jnp.einsum('thk,thkd->td', w, vv)

    return lax.map(one_block, xt).reshape(b, s, d)


def setup_inputs(seed: int = 0) -> dict:
    key = jax.random.key(seed)
    ks = jax.random.split(key, 20)
    nrm = jax.random.normal
    f32 = jnp.float32
    x = nrm(ks[0], (BATCH, SEQ, D_MODEL), f32)
    ln0_g = 1.0 + 0.02 * nrm(ks[1], (D_MODEL,), f32)
    ln0_b = 0.02 * nrm(ks[2], (D_MODEL,), f32)
    w_in = nrm(ks[3], (DEPTH, D_MODEL, D_IN_PROJ), f32) * D_MODEL ** -0.5
    b_gate = 0.01 * nrm(ks[4], (DEPTH, 2, D_MODEL), f32)
    q_norm_g = 1.0 + 0.02 * nrm(ks[5], (DEPTH, HEAD_DIM), f32)
    k_norm_g = 1.0 + 0.02 * nrm(ks[6], (DEPTH, HEAD_DIM), f32)
    w_branch_fourier = nrm(ks[7], (DEPTH, D_FOURIER, D_MODEL), f32) * D_FOURIER ** -0.5
    w_branch_attn = nrm(ks[8], (DEPTH, D_ATTN, D_MODEL), f32) * D_ATTN ** -0.5
    w_out = nrm(ks[9], (DEPTH, D_MODEL, D_MODEL), f32) * (DEEPNORM_BETA * D_MODEL ** -0.5)
    ln1_g = 1.0 + 0.02 * nrm(ks[10], (DEPTH, D_MODEL), f32)
    ln1_b = 0.02 * nrm(ks[11], (DEPTH, D_MODEL), f32)
    peer_w_query = nrm(ks[12], (DEPTH, D_MODEL, PEER_HEADS * PEER_QUERY_DIM), f32) * D_MODEL ** -0.5
    peer_sub_keys = nrm(ks[13], (DEPTH, PEER_HEADS, 2, PEER_N_KEYS, PEER_HALF), f32) * PEER_HALF ** -0.5
    peer_u = nrm(ks[14], (DEPTH, PEER_N_EXPERTS, D_MODEL), f32) * D_MODEL ** -0.5
    peer_v = nrm(ks[15], (DEPTH, PEER_N_EXPERTS, D_MODEL), f32) * (DEEPNORM_BETA * PEER_HEADS ** -0.5)
    ln2_g = 1.0 + 0.02 * nrm(ks[16], (DEPTH, D_MODEL), f32)
    ln2_b = 0.02 * nrm(ks[17], (DEPTH, D_MODEL), f32)
    return {"x": x, "ln0_g": ln0_g, "ln0_b": ln0_b, "w_in": w_in, "b_gate": b_gate,
            "q_norm_g": q_norm_g, "k_norm_g": k_norm_g,
            "w_branch_fourier": w_branch_fourier, "w_branch_attn": w_branch_attn,
            "w_out": w_out, "ln1_g": ln1_g, "ln1_b": ln1_b,
            "peer_w_query": peer_w_query, "peer_sub_keys": peer_sub_keys,
            "peer_u": peer_u, "peer_v": peer_v, "ln2_g": ln2_g, "ln2_b": ln2_b}


def reference(x, ln0_g, ln0_b, w_in, b_gate, q_norm_g, k_norm_g, w_branch_fourier,
              w_branch_attn, w_out, ln1_g, ln1_b, peer_w_query, peer_sub_keys,
              peer_u, peer_v, ln2_g, ln2_b):
    b, s, _ = x.shape
    x = layer_norm(x, ln0_g, ln0_b)
    cos, sin = axial_rope_tables(s, x.dtype)
    for l in range(DEPTH):
        h = x @ w_in[l]
        xf, q, k, v, g_f, g_a = jnp.split(h, SPLITS, axis=-1)
        y_f = fourier_mix(xf) @ w_branch_fourier[l]
        q = apply_axial_rope(rms_norm(q.reshape(b, s, N_Q_HEADS, HEAD_DIM), q_norm_g[l]), cos, sin)
        k = apply_axial_rope(rms_norm(k.reshape(b, s, N_KV_HEADS, HEAD_DIM), k_norm_g[l]), cos, sin)
        v = v.reshape(b, s, N_KV_HEADS, HEAD_DIM)
        y_a = block_attention(q, k, v) @ w_branch_attn[l]
        mixed = jax.nn.sigmoid(g_f + b_gate[l, 0]) * y_f + jax.nn.sigmoid(g_a + b_gate[l, 1]) * y_a
        x = layer_norm(DEEPNORM_ALPHA * x + mixed @ w_out[l], ln1_g[l], ln1_b[l])
        y_p = peer_ffn(x, peer_w_query[l], peer_sub_keys[l], peer_u[l], peer_v[l])
        x = layer_norm(DEEPNORM_ALPHA * x + y_p, ln2_g[l], ln2_b[l])
    return x
```

```cpp
#include <hip/hip_runtime.h>
#include <hip/hip_cooperative_groups.h>
#include <cstdio>
namespace cg = cooperative_groups;


typedef unsigned short u16;
using bf16x8 = __attribute__((ext_vector_type(8))) short;
using s16x4  = __attribute__((ext_vector_type(4))) short;
using f32x16 = __attribute__((ext_vector_type(16))) float;
using u32x4  = __attribute__((ext_vector_type(4))) unsigned;
using f32x2  = __attribute__((ext_vector_type(2))) float;
#define DI __device__ __forceinline__
#define MFMA(a, b, c) __builtin_amdgcn_mfma_f32_32x32x16_bf16((a), (b), (c), 0, 0, 0)

constexpr int T = 16384;
constexpr float ALPHA = 1.4142135623730951f;
constexpr int NTHR = 512;
constexpr int VSMEM = 73728;
constexpr int SMEM_BYTES = 2 * VSMEM;

struct P {
  const float *x, *ln0g, *ln0b, *w_in, *b_gate, *qng, *kng, *w_bf, *w_ba, *w_out, *ln1g, *ln1b, *w_q, *sk, *pu, *pv, *ln2g, *ln2b;
  float* out;
  u16 *WIN, *WBF, *WBA, *WOUT, *WQ, *SK, *D256, *C64;
  float2 *TW, *ROPE;
  float* XS;
  u16 *XB, *ZT, *GP, *Y, *Q, *K, *VT, *AO, *GATES, *MIXED, *QP;
  unsigned* BAR;
  unsigned char *U8, *V8;
  float *SU, *SV;
};

DI u16 f2bf(float f) { __bf16 h = (__bf16)f; return __builtin_bit_cast(u16, h); }
DI float bf2f(u16 h) { return __uint_as_float(((unsigned)h) << 16); }
DI unsigned pack2(float a, float b) { return (unsigned)f2bf(a) | ((unsigned)f2bf(b) << 16); }
DI float bflo(unsigned u) { return __uint_as_float(u << 16); }
DI float bfhi(unsigned u) { return __uint_as_float(u & 0xffff0000u); }
#define LAS __attribute__((address_space(3)))
DI int hw_slot() { return __builtin_amdgcn_s_getreg((5 << 11) | 4) & 63; }
DI volatile LAS int* wmap() { __shared__ int wm_[64]; return (volatile LAS int*)wm_; }
DI int lane_id() { int l; asm volatile("v_mbcnt_lo_u32_b32 %0, -1, 0\n\tv_mbcnt_hi_u32_b32 %0, -1, %0" : "=&v"(l)); return l; }
DI int opaque_tid() { int w = wmap()[hw_slot()]; int t = (w << 6) | lane_id(); asm volatile("" : "+v"(t)); return t; }
DI int opaque_vtid() { return opaque_tid() & 255; }
template <int M> DI int shxi(int v) {
  if constexpr (M < 32) return __builtin_amdgcn_ds_swizzle(v, (M << 10) | 0x1f);
  else { int a = (lane_id() ^ 32) << 2; asm volatile("" : "+v"(a)); return __builtin_amdgcn_ds_bpermute(a, v); }
}
template <int M> DI float shx(float v) { return __int_as_float(shxi<M>(__float_as_int(v))); }
DI float wave_sum(float v) {
  v += shx<32>(v); v += shx<16>(v); v += shx<8>(v); v += shx<4>(v); v += shx<2>(v); v += shx<1>(v);
  return v;
}

template <int MT>
DI void gemm_main(const u16* __restrict__ A, long lda, const u16* __restrict__ B, long ldb, int K,
                  f32x16 (&acc)[MT][2], char* smem, const int  , const int rot = 0) {
  constexpr int STAGE = (64 * MT + 256) * 72;
  u16* s0 = (u16*)smem;
  const int tid = opaque_tid();
  const int lane = tid & 63, wave = tid >> 6;
  const int wm = wave >> 2, wn = wave & 3;
  const int lr = tid >> 3, lc = (tid & 7) * 8;
  const u16* Ap = A + (long)lr * lda + lc;
  const u16* Bp = B + (long)lr * ldb + lc;
  u32x4 ra[MT], rb[4];
  const int nk = K >> 6;
#define G_LOAD(kt)                                                                                      \
  _Pragma("unroll") for (int c = 0; c < MT; c++) ra[c] = *(const u32x4*)(Ap + (long)(64 * c) * lda + (((kt) + rot) & (nk - 1)) * 64); \
  _Pragma("unroll") for (int c = 0; c < 4; c++) rb[c] = *(const u32x4*)(Bp + (long)(64 * c) * ldb + (((kt) + rot) & (nk - 1)) * 64);
#define G_STORE(st)                                                                                     \
  { u16* sA_ = s0 + (st) * STAGE; u16* sB_ = sA_ + 64 * MT * 72;                                        \
    _Pragma("unroll") for (int c = 0; c < MT; c++) *(u32x4*)(sA_ + (lr + 64 * c) * 72 + lc) = ra[c];    \
    _Pragma("unroll") for (int c = 0; c < 4; c++) *(u32x4*)(sB_ + (lr + 64 * c) * 72 + lc) = rb[c]; }
#define G_COMPUTE(st)                                                                                   \
  { const u16* sA_ = s0 + (st) * STAGE; const u16* sB_ = sA_ + 64 * MT * 72;                            \
    _Pragma("unroll") for (int kk = 0; kk < 4; kk++) {                                                  \
      bf16x8 af[MT], bfr[2];                                                                            \
      _Pragma("unroll") for (int i = 0; i < MT; i++) af[i] = *(const bf16x8*)(sA_ + (wm * 32 * MT + i * 32 + (lane & 31)) * 72 + kk * 16 + (lane >> 5) * 8); \
      _Pragma("unroll") for (int j = 0; j < 2; j++) bfr[j] = *(const bf16x8*)(sB_ + (wn * 64 + j * 32 + (lane & 31)) * 72 + kk * 16 + (lane >> 5) * 8);     \
      _Pragma("unroll") for (int i = 0; i < MT; i++)                                                    \
        _Pragma("unroll") for (int j = 0; j < 2; j++) acc[i][j] = MFMA(af[i], bfr[j], acc[i][j]);       \
      if (MT > 2) __builtin_amdgcn_sched_barrier(0);                                                    \
    } }
  G_LOAD(0)
  __syncthreads();
  G_STORE(0)
  G_LOAD((1 < nk ? 1 : 0))
  __syncthreads();
  const bool late = __builtin_amdgcn_readfirstlane(wave) >= 4;
  for (int t = 0; t < nk; t++) {
    if (!late) {
      if (t + 1 < nk) { G_STORE((t + 1) & 1) }
      if (t + 2 < nk) { G_LOAD(t + 2) }
    }
    __builtin_amdgcn_s_setprio(1);
    G_COMPUTE(t & 1)
    __builtin_amdgcn_s_setprio(0);
    if (late) {
      if (t + 1 < nk) { G_STORE((t + 1) & 1) }
      if (t + 2 < nk) { G_LOAD(t + 2) }
    }
    __syncthreads();
  }
#undef G_LOAD
#undef G_STORE
#undef G_COMPUTE
}

struct Xcd { int id, slot, n; };
#define XCD_TILE_LOOP(MTOT, NTOT, mt, nt)                                             \
  for (int j_ = xc.slot, mt, nt; j_ < ((MTOT) / 8) * (NTOT) && (mt = xc.id * ((MTOT) / 8) + j_ % ((MTOT) / 8), nt = j_ / ((MTOT) / 8), true); j_ += xc.n)

template <int MT>
DI void zero_acc(f32x16 (&acc)[MT][2]) {
#pragma unroll
  for (int i = 0; i < MT; i++)
#pragma unroll
    for (int j = 0; j < 2; j++)
#pragma unroll
      for (int r = 0; r < 16; r++) acc[i][j][r] = 0.f;
}

DI void stage_q(f32x16 (&acc)[4][2], float* sC, const int tid, const int mh, const int nh) {
  const int lane = tid & 63, wave = tid >> 6, wm = wave >> 2, wn = wave & 3;
  if (wm == mh && (wn >> 1) == nh) {
#pragma unroll
    for (int i = 0; i < 4; i++)
#pragma unroll
      for (int j = 0; j < 2; j++)
#pragma unroll
        for (int r = 0; r < 16; r++) {
          int row = i * 32 + 8 * (r >> 2) + 4 * (lane >> 5) + (r & 3);
          int col = (wn & 1) * 64 + j * 32 + (lane & 31);
          sC[row * 132 + col] = acc[i][j][r];
        }
  }
  __syncthreads();
}
DI void stage_q_tr(f32x16 (&acc)[4][2], float* sC, const int tid, const int mh, const int nh) {
  const int lane = tid & 63, wave = tid >> 6, wm = wave >> 2, wn = wave & 3;
  if (wm == mh && (wn >> 1) == nh) {
#pragma unroll
    for (int i = 0; i < 4; i++)
#pragma unroll
      for (int j = 0; j < 2; j++)
#pragma unroll
        for (int rq = 0; rq < 4; rq++) {
          int row = i * 32 + 8 * rq + 4 * (lane >> 5);
          int col = (wn & 1) * 64 + j * 32 + (lane & 31);
          float4 v = make_float4(acc[i][j][rq * 4], acc[i][j][rq * 4 + 1], acc[i][j][rq * 4 + 2], acc[i][j][rq * 4 + 3]);
          *(float4*)(sC + col * 132 + row) = v;
        }
  }
  __syncthreads();
}
DI void unstage_q(f32x16 (&acc)[4][2], const float* sC, const int tid, const int mh, const int nh) {
  const int lane = tid & 63, wave = tid >> 6, wm = wave >> 2, wn = wave & 3;
  if (wm == mh && (wn >> 1) == nh) {
#pragma unroll
    for (int i = 0; i < 4; i++)
#pragma unroll
      for (int j = 0; j < 2; j++)
#pragma unroll
        for (int r = 0; r < 16; r++) {
          int row = i * 32 + 8 * (r >> 2) + 4 * (lane >> 5) + (r & 3);
          int col = (wn & 1) * 64 + j * 32 + (lane & 31);
          acc[i][j][r] = sC[row * 132 + col];
        }
  }
  __syncthreads();
}
DI void stage_h1(f32x16 (&acc)[1][2], float* sC, const int tid, const int nh) {
  const int lane = tid & 63, wave = tid >> 6, wm = wave >> 2, wn = wave & 3;
  if ((wn >> 1) == nh) {
#pragma unroll
    for (int j = 0; j < 2; j++)
#pragma unroll
      for (int r = 0; r < 16; r++) {
        int row = wm * 32 + 8 * (r >> 2) + 4 * (lane >> 5) + (r & 3);
        int col = (wn & 1) * 64 + j * 32 + (lane & 31);
        sC[row * 132 + col] = acc[0][j][r];
      }
  }
  __syncthreads();
}

DI void ln16_write(float (&v)[16], const float* g, const float* bt, float* dstf, u16* dstb, int lane) {
  float s = 0.f;
#pragma unroll
  for (int i = 0; i < 16; i++) s += v[i];
  float mu = wave_sum(s) * (1.f / 1024.f);
  float q = 0.f;
#pragma unroll
  for (int i = 0; i < 16; i++) { float d = v[i] - mu; q += d * d; }
  float rstd = rsqrtf(wave_sum(q) * (1.f / 1024.f) + 1e-5f);
#pragma unroll
  for (int c = 0; c < 4; c++) {
    int e = (lane + 64 * c) * 4;
    float4 gg = *(const float4*)(g + e), bb = *(const float4*)(bt + e);
    float4 o;
    o.x = (v[c * 4 + 0] - mu) * rstd * gg.x + bb.x;
    o.y = (v[c * 4 + 1] - mu) * rstd * gg.y + bb.y;
    o.z = (v[c * 4 + 2] - mu) * rstd * gg.z + bb.z;
    o.w = (v[c * 4 + 3] - mu) * rstd * gg.w + bb.w;
    if (dstf) *(float4*)(dstf + e) = o;
    if (dstb) { uint2 pk; pk.x = pack2(o.x, o.y); pk.y = pack2(o.z, o.w); *(uint2*)(dstb + e) = pk; }
  }
}

DI void transpose_tile(const float* __restrict__ src, int ldsrc, u16* __restrict__ dst, int lddst, float* tile  , const int tid, const bool act) {
  __syncthreads();
#pragma unroll
  for (int i = 0; i < 4; i++) {
    int r = (tid >> 4) + 16 * i, c4 = (tid & 15) * 4;
    float4 v = *(const float4*)(src + (long)r * ldsrc + c4);
    tile[r * 65 + c4] = v.x; tile[r * 65 + c4 + 1] = v.y; tile[r * 65 + c4 + 2] = v.z; tile[r * 65 + c4 + 3] = v.w;
  }
  __syncthreads();
#pragma unroll
  for (int i = 0; i < 2; i++) {
    int unit = tid + 256 * i, n = unit >> 3, ch = unit & 7;
    uint4 o;
    o.x = pack2(tile[(ch * 8 + 0) * 65 + n], tile[(ch * 8 + 1) * 65 + n]);
    o.y = pack2(tile[(ch * 8 + 2) * 65 + n], tile[(ch * 8 + 3) * 65 + n]);
    o.z = pack2(tile[(ch * 8 + 4) * 65 + n], tile[(ch * 8 + 5) * 65 + n]);
    o.w = pack2(tile[(ch * 8 + 6) * 65 + n], tile[(ch * 8 + 7) * 65 + n]);
    if (act) *(uint4*)(dst + (long)n * lddst + ch * 8) = o;
  }
}

DI void ph_prep(const P& p, char* smem, int bid, int nb) {
  constexpr int VT = 256;
  const int tid = opaque_vtid(), lane = tid & 63, wave = tid >> 6;
  for (int row = bid * 4 + wave; row < T; row += nb * 4) {
    const float* src = p.x + (long)row * 1024;
    float v[16];
#pragma unroll
    for (int c = 0; c < 4; c++) { float4 t = *(const float4*)(src + (lane + 64 * c) * 4); v[c * 4] = t.x; v[c * 4 + 1] = t.y; v[c * 4 + 2] = t.z; v[c * 4 + 3] = t.w; }
    int b = row >> 13, s = row & 8191;
    int tp = (b << 13) + (s & 63) * 128 + (s >> 6);
    ln16_write(v, p.ln0g, p.ln0b, p.XS + (long)tp * 1024, p.XB + (long)tp * 1024, lane);
  }
  for (int r = bid * 4 + wave; r < 65536; r += nb * 4) {
    const int tb = r >> 15, rr = r & 32767;
    const float* src = (tb ? p.pv : p.pu) + (long)rr * 1024;
    float v[16];
#pragma unroll
    for (int c = 0; c < 4; c++) { float4 t = *(const float4*)(src + (lane + 64 * c) * 4); v[c * 4] = t.x; v[c * 4 + 1] = t.y; v[c * 4 + 2] = t.z; v[c * 4 + 3] = t.w; }
    float am = 0.f;
#pragma unroll
    for (int i = 0; i < 16; i++) am = fmaxf(am, fabsf(v[i]));
    { am = fmaxf(am, shx<32>(am)); am = fmaxf(am, shx<16>(am)); am = fmaxf(am, shx<8>(am)); am = fmaxf(am, shx<4>(am)); am = fmaxf(am, shx<2>(am)); am = fmaxf(am, shx<1>(am)); }
    const float inv = am > 0.f ? 127.f / am : 0.f;
    unsigned char* dst = (tb ? p.V8 : p.U8) + (long)rr * 1024;
#pragma unroll
    for (int c = 0; c < 4; c++) {
      unsigned q0 = (unsigned)((int)rintf(v[c * 4] * inv) + 128), q1 = (unsigned)((int)rintf(v[c * 4 + 1] * inv) + 128);
      unsigned q2 = (unsigned)((int)rintf(v[c * 4 + 2] * inv) + 128), q3 = (unsigned)((int)rintf(v[c * 4 + 3] * inv) + 128);
      *(unsigned*)(dst + (lane + 64 * c) * 4) = q0 | (q1 << 8) | (q2 << 16) | (q3 << 24);
    }
    if (lane == 0) (tb ? p.SV : p.SU)[rr] = am * (1.f / 127.f);
  }
  for (int i = bid * VT + tid; i < 2 * 8 * 2 * 128 * 128 / 8; i += nb * VT) {
    const float* s = p.sk + (long)i * 8;
    float4 a = *(const float4*)s, b = *(const float4*)(s + 4);
    uint4 o; o.x = pack2(a.x, a.y); o.y = pack2(a.z, a.w); o.z = pack2(b.x, b.y); o.w = pack2(b.z, b.w);
    *(uint4*)(p.SK + (long)i * 8) = o;
  }
  {
    float* tile = (float*)smem;
    const int per_layer = 704 + 128 + 128 + 256 + 512;
    for (int it0 = 0; it0 < 2 * per_layer; it0 += nb) {
      int it = it0 + bid; const bool act = it < 2 * per_layer; if (!act) it = 0;
      int l = it / per_layer, r = it % per_layer;
      const float* src; u16* dst; int ldsrc, lddst, kt, nt;
      if (r < 704) { kt = r / 44; nt = r % 44; src = p.w_in + (long)l * 1024 * 3328 + 512; ldsrc = 3328; dst = p.WIN + ((long)l * 3328 + 512) * 1024; lddst = 1024; }
      else if (r < 832) { r -= 704; kt = r / 16; nt = r % 16; src = p.w_bf + (long)l * 512 * 1024; ldsrc = 1024; dst = p.WBF + (long)l * 1024 * 512; lddst = 512; }
      else if (r < 960) { r -= 832; kt = r / 16; nt = r % 16; src = p.w_ba + (long)l * 512 * 1024; ldsrc = 1024; dst = p.WBA + (long)l * 1024 * 512; lddst = 512; }
      else if (r < 1216) { r -= 960; kt = r / 16; nt = r % 16; src = p.w_out + (long)l * 1024 * 1024; ldsrc = 1024; dst = p.WOUT + (long)l * 1024 * 1024; lddst = 1024; }
      else { r -= 1216; kt = r / 32; nt = r % 32; src = p.w_q + (long)l * 1024 * 2048; ldsrc = 2048; dst = p.WQ + (long)l * 2048 * 1024; lddst = 1024; }
      transpose_tile(src + (long)kt * 64 * ldsrc + nt * 64, ldsrc, dst + (long)nt * 64 * lddst + kt * 64, lddst, tile, tid, act);
    }
    __syncthreads();
  }
  {
    float* wt = (float*)smem;
    float* ctab = wt + 16 * 128;
    if (tid < 128) ctab[tid] = cospif((float)tid / 64.f);
    for (int it0 = 0; it0 < 2 * 4 * 64; it0 += nb) {
      int it = it0 + bid; const bool act = it < 2 * 4 * 64; if (!act) it = 0;
      int l = it >> 8, g = (it >> 6) & 3, kt = it & 63;
      __syncthreads();
      for (int e = tid; e < 16 * 32; e += VT) {
        int kr = e >> 5, c4 = (e & 31) * 4;
        *(float4*)(wt + kr * 128 + c4) = *(const float4*)(p.w_in + ((long)l * 1024 + kt * 16 + kr) * 3328 + g * 128 + c4);
      }
      __syncthreads();
      int j = tid & 127, kh = tid >> 7;
      int cp, off; float sgn;
      if (j < 65) { cp = j; off = 0; sgn = 0.08838834764831845f; } else { cp = j - 64; off = 96; sgn = -0.08838834764831845f; }
      float a[8];
#pragma unroll
      for (int q = 0; q < 8; q++) a[q] = 0.f;
      for (int d = 0; d < 128; d++) {
        float bs = ctab[(cp * d + off) & 127];
#pragma unroll
        for (int q = 0; q < 8; q++) a[q] += wt[(kh * 8 + q) * 128 + d] * bs;
      }
      uint4 o; o.x = pack2(a[0] * sgn, a[1] * sgn); o.y = pack2(a[2] * sgn, a[3] * sgn); o.z = pack2(a[4] * sgn, a[5] * sgn); o.w = pack2(a[6] * sgn, a[7] * sgn);
      if (act) *(uint4*)(p.WIN + ((long)l * 3328 + g * 128 + j) * 1024 + kt * 16 + kh * 8) = o;
    }
    __syncthreads();
  }
  for (int i = bid * VT + tid; i < 65536; i += nb * VT) {
    int m = i >> 8, kk = i & 255;
    int mh = m >> 7, po = (m >> 6) & 1, k1 = mh * 64 + (m & 63);
    int pi = kk >> 7, s1 = kk & 127;
    int a = (k1 * s1) & 127;
    float c = cospif((float)a / 64.f), s = sinpif((float)a / 64.f);
    float v = (po == pi) ? c : (po == 0 ? s : -s);
    p.D256[i] = f2bf(v * 0.08838834764831845f);
  }
  for (int i = bid * VT + tid; i < 8192; i += nb * VT) {
    int k2 = i >> 7, kk = i & 127, pi = kk >> 6, s2 = kk & 63;
    int a = (k2 * s2) & 63;
    float v = pi ? sinpif((float)a / 32.f) : cospif((float)a / 32.f);
    p.C64[i] = f2bf(v * 0.125f);
    int k1 = i >> 6, t2 = i & 63;
    float ph = (float)(k1 * t2) / 4096.f;
    p.TW[i] = make_float2(cospif(ph), sinpif(ph));
  }
  for (int i = bid * VT + tid; i < 2048; i += nb * VT) {
    int pos = i >> 4, f = i & 15;
    float inv = 1.0f / powf(10000.f, (float)(2 * f) / 32.f);
    float ang = (float)pos * inv;
    p.ROPE[i] = make_float2(cosf(ang), sinf(ang));
  }
}

DI void inproj_epi_fourier(const P& p, const float* sC, int mt, int g, const int tid) {
  const int b = mt >> 6, s2 = mt & 63;
#pragma unroll 1
  for (int unit = tid; unit < 2048; unit += NTHR) {
    int j = unit >> 4, ch = unit & 15;
    float4 a = *(const float4*)(sC + j * 132 + ch * 8), c = *(const float4*)(sC + j * 132 + ch * 8 + 4);
    uint4 o; o.x = pack2(a.x, a.y); o.y = pack2(a.z, a.w); o.z = pack2(c.x, c.y); o.w = pack2(c.z, c.w);
    int cp = (j < 65) ? j : j - 64, part = (j < 65) ? 0 : 1;
    long rowi = ((long)(b * 4 + g) * 65 + cp) * 64 + s2;
    *(uint4*)(p.ZT + rowi * 256 + part * 128 + ch * 8) = o;
  }
  if (tid < 32) {
    int cp = (tid < 16) ? 0 : 64, ch = tid & 15;
    long rowi = ((long)(b * 4 + g) * 65 + cp) * 64 + s2;
    unsigned z_; asm volatile("v_mov_b32 %0, 0" : "=v"(z_));
    *(uint4*)(p.ZT + rowi * 256 + 128 + ch * 8) = make_uint4(z_, z_, z_, z_);
  }
}
DI void inproj_epi_qk(const P& p, int l, const float* sC, int mt, int nt, const int tid) {
  const int b = mt >> 6, s2 = mt & 63;
  if (tid < 256) {
    const int row = tid & 127, hd = tid >> 7;
    const float* sr = sC + row * 132 + hd * 64;
    float ss = 0.f;
#pragma unroll
    for (int i = 0; i < 16; i++) { float4 t = *(const float4*)(sr + i * 4); ss += t.x * t.x + t.y * t.y + t.z * t.z + t.w * t.w; }
    const bool isq = nt < 8;
    const float* gn = (isq ? p.qng : p.kng) + l * 64;
    const float rinv = rsqrtf(ss * (1.f / 64.f) + 1e-6f) * (isq ? (0.125f * 1.4426950408889634f) : 1.f);
    const int s1 = row;
    const int u = s2 * 128 + s1;
    u16* dst;
    if (isq) { int h = (nt - 4) * 2 + hd; dst = p.Q + ((long)(b * 8 + h) * 8192 + u) * 64; }
    else { dst = p.K + ((long)(b * 2 + hd) * 8192 + u) * 64; }
#pragma unroll 1
    for (int ax = 0; ax < 2; ax++) {
      const int pos = ax ? s2 : s1;
#pragma unroll 1
      for (int fq = 0; fq < 2; fq++) {
        float x0[8], x1[8], o0[8], o1[8];
#pragma unroll
        for (int e = 0; e < 8; e++) {
          int d0 = ax * 32 + fq * 8 + e, d1 = d0 + 16;
          x0[e] = sr[d0] * rinv * gn[d0];
          x1[e] = sr[d1] * rinv * gn[d1];
          float2 cs = p.ROPE[pos * 16 + fq * 8 + e];
          o0[e] = x0[e] * cs.x - x1[e] * cs.y;
          o1[e] = x1[e] * cs.x + x0[e] * cs.y;
        }
        uint4 pk;
        pk.x = pack2(o0[0], o0[1]); pk.y = pack2(o0[2], o0[3]); pk.z = pack2(o0[4], o0[5]); pk.w = pack2(o0[6], o0[7]);
        *(uint4*)(dst + ax * 32 + fq * 8) = pk;
        pk.x = pack2(o1[0], o1[1]); pk.y = pack2(o1[2], o1[3]); pk.z = pack2(o1[4], o1[5]); pk.w = pack2(o1[6], o1[7]);
        *(uint4*)(dst + ax * 32 + 16 + fq * 8) = pk;
      }
    }
  }
}
DI void inproj_epi_v(const P& p, const float* sC, int mt, const int tid) {
  const int b = mt >> 6, s2 = mt & 63;
#pragma unroll 1
  for (int unit = tid; unit < 2048; unit += NTHR) {
    int j = unit >> 4, ch = unit & 15;
    float4 a = *(const float4*)(sC + j * 132 + ch * 8), c = *(const float4*)(sC + j * 132 + ch * 8 + 4);
    uint4 o; o.x = pack2(a.x, a.y); o.y = pack2(a.z, a.w); o.z = pack2(c.x, c.y); o.w = pack2(c.z, c.w);
    *(uint4*)(p.VT + ((long)(b * 2) * 64 + j) * 8192 + s2 * 128 + ch * 8) = o;
  }
}
DI void inproj_epi_gates(const P& p, int l, const float* sC, int mt, int nt, const int tid) {
  const int c0 = (nt - 10) * 128;
  const float* bg = p.b_gate + l * 2048 + c0;
#pragma unroll 1
  for (int unit = tid; unit < 2048; unit += NTHR) {
    int row = unit >> 4, ch = unit & 15;
    float4 a = *(const float4*)(sC + row * 132 + ch * 8), c = *(const float4*)(sC + row * 132 + ch * 8 + 4);
    float4 ba = *(const float4*)(bg + ch * 8), bc = *(const float4*)(bg + ch * 8 + 4);
    float r0 = 1.f / (1.f + __expf(-(a.x + ba.x))), r1 = 1.f / (1.f + __expf(-(a.y + ba.y)));
    float r2 = 1.f / (1.f + __expf(-(a.z + ba.z))), r3 = 1.f / (1.f + __expf(-(a.w + ba.w)));
    float r4 = 1.f / (1.f + __expf(-(c.x + bc.x))), r5 = 1.f / (1.f + __expf(-(c.y + bc.y)));
    float r6 = 1.f / (1.f + __expf(-(c.z + bc.z))), r7 = 1.f / (1.f + __expf(-(c.w + bc.w)));
    uint4 o; o.x = pack2(r0, r1); o.y = pack2(r2, r3); o.z = pack2(r4, r5); o.w = pack2(r6, r7);
    *(uint4*)(p.GATES + ((long)mt * 128 + row) * 2048 + c0 + ch * 8) = o;
  }
}

DI void ph_inproj(const P& p, int l, char* smem, int bid, int nb, const Xcd xc) {
  const int tid = opaque_tid();
  float* sC = (float*)smem;
  const u16* W = p.WIN + (long)l * 3328 * 1024;
  XCD_TILE_LOOP(64, 12, mt2, nt2) {
    f32x16 acc[4][2];
    zero_acc<4>(acc);
    gemm_main<4>(p.XB + (long)mt2 * 256 * 1024, 1024, W + (long)nt2 * 256 * 1024, 1024, 1024, acc, smem, tid, j_);
#pragma unroll 1
    for (int q = 0; q < 4; q++) {
      const int mh = q >> 1, nh = q & 1, mt = mt2 * 2 + mh, nt = nt2 * 2 + nh;
      if (nt < 4) { stage_q_tr(acc, sC, tid, mh, nh); inproj_epi_fourier(p, sC, mt, nt, opaque_tid()); }
      else if (nt < 9) { stage_q(acc, sC, tid, mh, nh); inproj_epi_qk(p, l, sC, mt, nt, opaque_tid()); }
      else if (nt == 9) { stage_q_tr(acc, sC, tid, mh, nh); inproj_epi_v(p, sC, mt, opaque_tid()); }
      else { stage_q(acc, sC, tid, mh, nh); inproj_epi_gates(p, l, sC, mt, nt, opaque_tid()); }
      __syncthreads();
    }
  }
  for (int j_ = xc.slot; j_ < 32; j_ += xc.n) {
    const int mt4 = xc.id * 32 + j_;
    f32x16 acc1[1][2];
    zero_acc<1>(acc1);
    gemm_main<1>(p.XB + (long)mt4 * 64 * 1024, 1024, W + (long)12 * 256 * 1024, 1024, 1024, acc1, smem, tid, j_);
#pragma unroll 1
    for (int nh = 0; nh < 2; nh++) {
      stage_h1(acc1, sC, tid, nh);
      const int c0 = (24 + nh - 10) * 128;
      const float* bg = p.b_gate + l * 2048 + c0;
#pragma unroll 1
      for (int unit = opaque_tid(); unit < 1024; unit += NTHR) {
        int row = unit >> 4, ch = unit & 15;
        float4 a = *(const float4*)(sC + row * 132 + ch * 8), c = *(const float4*)(sC + row * 132 + ch * 8 + 4);
        float4 ba = *(const float4*)(bg + ch * 8), bc = *(const float4*)(bg + ch * 8 + 4);
        float r0 = 1.f / (1.f + __expf(-(a.x + ba.x))), r1 = 1.f / (1.f + __expf(-(a.y + ba.y)));
        float r2 = 1.f / (1.f + __expf(-(a.z + ba.z))), r3 = 1.f / (1.f + __expf(-(a.w + ba.w)));
        float r4 = 1.f / (1.f + __expf(-(c.x + bc.x))), r5 = 1.f / (1.f + __expf(-(c.y + bc.y)));
        float r6 = 1.f / (1.f + __expf(-(c.z + bc.z))), r7 = 1.f / (1.f + __expf(-(c.w + bc.w)));
        uint4 o; o.x = pack2(r0, r1); o.y = pack2(r2, r3); o.z = pack2(r4, r5); o.w = pack2(r6, r7);
        *(uint4*)(p.GATES + ((long)mt4 * 64 + row) * 2048 + c0 + ch * 8) = o;
      }
      __syncthreads();
    }
  }
}

DI void ph_fftA(const P& p, char* smem, int bid, int nb) {
  const int tid = opaque_tid();
  float* sC = (float*)smem;
  for (int t2 = bid; t2 < 130; t2 += nb) {
    f32x16 acc[4][2];
    zero_acc<4>(acc);
    gemm_main<4>(p.D256, 256, p.ZT + (long)t2 * 256 * 256, 256, 256, acc, smem, tid, t2);
#pragma unroll 1
    for (int q = 0; q < 4; q++) {
      const int mh = q >> 1, nh = q & 1, ntile = t2 * 2 + nh;
      stage_q(acc, sC, tid, mh, nh);
      if (tid < 256) {
        const int k1l = tid & 63, ch = (tid >> 6) & 1, po = tid >> 7;
        const int k1 = mh * 64 + k1l;
        const int qd = ntile * 2 + ch, bg = qd / 65, cp = qd % 65;
        u16* dst = p.GP + (((long)bg * 128 + k1) * 65 + cp) * 128 + po * 64;
        const float2* tw = p.TW + k1 * 64;
#pragma unroll 2
        for (int i = 0; i < 8; i++) {
          float o[8];
#pragma unroll
          for (int e = 0; e < 8; e++) {
            int s2 = i * 8 + e;
            float gr = sC[k1l * 132 + ch * 64 + s2], gi = sC[(64 + k1l) * 132 + ch * 64 + s2];
            float2 cs = tw[s2];
            o[e] = po ? (gi * cs.x - gr * cs.y) : (gr * cs.x + gi * cs.y);
          }
          uint4 pk; pk.x = pack2(o[0], o[1]); pk.y = pack2(o[2], o[3]); pk.z = pack2(o[4], o[5]); pk.w = pack2(o[6], o[7]);
          *(uint4*)(dst + i * 8) = pk;
        }
      }
      __syncthreads();
    }
  }
}

DI void ph_fftC(const P& p, char* smem, int bid, int nb) {
  const int tid = opaque_tid();
  float* sC = (float*)smem;
  for (int t2 = bid; t2 < 260; t2 += nb) {
    f32x16 acc[1][2];
    zero_acc<1>(acc);
    gemm_main<1>(p.C64, 128, p.GP + (long)t2 * 256 * 128, 128, 128, acc, smem, tid, 0);
#pragma unroll 1
    for (int nh = 0; nh < 2; nh++) {
      stage_h1(acc, sC, tid, nh);
      const int tile = t2 * 2 + nh;
      const int nl = tid & 127, kh = tid >> 7;
      const int idx = tile * 128 + nl;
      const int cp = idx % 65, k1 = (idx / 65) & 127, bg = idx / (65 * 128);
      const int b = bg >> 2, g = bg & 3;
      const bool mir = (cp >= 1 && cp <= 63);
      for (int i = 0; i < 16; i++) {
        int k2 = kh * 16 + i;
        u16 v = f2bf(sC[k2 * 132 + nl]);
        int k = k1 + 128 * k2;
        long tp = (long)b * 8192 + (k & 63) * 128 + (k >> 6);
        p.Y[tp * 512 + g * 128 + cp] = v;
        if (mir) {
          int km = (8192 - k) & 8191;
          long tm = (long)b * 8192 + (km & 63) * 128 + (km >> 6);
          p.Y[tm * 512 + g * 128 + 128 - cp] = v;
        }
      }
      __syncthreads();
    }
  }
}

DI void attn_item(const P& p, int l, int item, char* smem, const int tid, const int rot, const bool late) {
  const int lane = tid & 63, wave = tid >> 6;
  const int hg = item & 3, qb = (item >> 2) & 31, kvh = (item >> 7) & 1, b = item >> 8;
  const int h = kvh * 4 + hg;
  const int ql = lane & 31, hf = lane >> 5;
  const u16* Qp = p.Q + ((long)(b * 8 + h) * 8192 + qb * 256 + wave * 64) * 64;
  const u16* Kp = p.K + (long)(b * 2 + kvh) * 8192 * 64;
  const u16* Vp = p.VT + (long)(b * 2 + kvh) * 64 * 8192;
  u16* sK = (u16*)smem;
  u16* sV = sK + 3 * 64 * 72;
  f32x16 o[2][2];
#pragma unroll
  for (int dt = 0; dt < 2; dt++)
#pragma unroll
    for (int qt = 0; qt < 2; qt++)
#pragma unroll
      for (int r = 0; r < 16; r++) o[dt][qt][r] = 0.f;
  f32x2 ls[2] = {f32x2{0.f, 0.f}, f32x2{0.f, 0.f}};
  const int lr = tid >> 3, lc = (tid & 7) * 8;
  u32x4 rk[2], rv[2];
  __syncthreads();
#pragma unroll
  for (int c = 0; c < 2; c++) {
    rk[c] = *(const u32x4*)((const char*)Kp + ((long)(rot & 127) * 8192 + c * 4096) + (unsigned)((lr * 64 + lc) * 2));
    rv[c] = *(const u32x4*)((const char*)Vp + ((long)(rot & 127) * 128 + (long)c * 32 * 8192 * 2) + (unsigned)((lr * 8192 + lc) * 2));
  }
#pragma unroll
  for (int c = 0; c < 2; c++) {
    *(u32x4*)(sK + (lr + 32 * c) * 72 + lc) = rk[c];
    *(u32x4*)(sV + (lr + 32 * c) * 72 + lc) = rv[c];
  }
  __syncthreads();
  __builtin_amdgcn_sched_barrier(0);
  bf16x8 qf[2][4];
  float bound[2];
  float kmax = fabsf(p.kng[l * 64 + lane]);
  { kmax = fmaxf(kmax, shx<32>(kmax)); kmax = fmaxf(kmax, shx<16>(kmax)); kmax = fmaxf(kmax, shx<8>(kmax)); kmax = fmaxf(kmax, shx<4>(kmax)); kmax = fmaxf(kmax, shx<2>(kmax)); kmax = fmaxf(kmax, shx<1>(kmax)); }
  kmax *= 8.f * 1.02f;
#pragma unroll
  for (int qt = 0; qt < 2; qt++) {
    float ssq = 0.f;
#pragma unroll
    for (int kd = 0; kd < 4; kd++) {
      qf[qt][kd] = *(const bf16x8*)((const char*)Qp + (long)((qt * 32 * 64 + kd * 16) * 2) + (unsigned)((ql * 64 + hf * 8) * 2));
#pragma unroll
      for (int j = 0; j < 8; j++) { float v = bf2f((u16)qf[qt][kd][j]); ssq += v * v; }
    }
    ssq += shx<32>(ssq);
    bound[qt] = sqrtf(ssq) * kmax;
    __builtin_amdgcn_sched_barrier(0);
  }
  const unsigned offK = (unsigned)((lr * 64 + lc) * 2), offV = (unsigned)((lr * 8192 + lc) * 2);
  const char* Kb = (const char*)Kp;
  const char* Vb = (const char*)Vp;
#define ATT_LOAD(ktile)                                                                                   \
  { const long tk_ = (long)(((ktile) + rot) & 127);                                                       \
    rk[0] = *(const u32x4*)(Kb + tk_ * 8192 + offK); rk[1] = *(const u32x4*)(Kb + (tk_ * 8192 + 4096) + offK);          \
    rv[0] = *(const u32x4*)(Vb + tk_ * 128 + offV);  rv[1] = *(const u32x4*)(Vb + (tk_ * 128 + 32 * 8192 * 2) + offV); }
#define ATT_STORE(buf3)                                                                                   \
  { u16* nK = sK + (buf3) * 64 * 72; u16* nV = sV + (buf3) * 64 * 72;                                     \
    _Pragma("unroll") for (int c = 0; c < 2; c++) {                                                       \
      *(u32x4*)(nK + (lr + 32 * c) * 72 + lc) = rk[c];                                                    \
      *(u32x4*)(nV + (lr + 32 * c) * 72 + lc) = rv[c];                                                    \
    } }
#define ATT_QKEXP(ks)                                                                                     \
    {                                                                                                     \
      _Pragma("unroll") for (int qt = 0; qt < 2; qt++)                                                    \
        _Pragma("unroll") for (int r = 0; r < 16; r++) st[qt][r] = -bound[qt];                            \
      _Pragma("unroll") for (int kd = 0; kd < 4; kd++) {                                                  \
        bf16x8 kf = *(const bf16x8*)(cK + ((ks) * 32 + ql) * 72 + kd * 16 + hf * 8);                      \
        _Pragma("unroll") for (int qt = 0; qt < 2; qt++) st[qt] = MFMA(kf, qf[qt][kd], st[qt]);           \
      }                                                                                                   \
      _Pragma("unroll") for (int qt = 0; qt < 2; qt++)                                                    \
        _Pragma("unroll") for (int r = 0; r < 16; r += 2) {                                               \
          float e0 = __builtin_amdgcn_exp2f(st[qt][r]), e1 = __builtin_amdgcn_exp2f(st[qt][r + 1]);      \
          st[qt][r] = e0; st[qt][r + 1] = e1;                                                             \
          ls[qt] += f32x2{e0, e1};                                                                        \
        }                                                                                                 \
    }
#define ATT_PV(ks)                                                                                        \
    {                                                                                                     \
      _Pragma("unroll") for (int s = 0; s < 2; s++) {                                                     \
        bf16x8 pf[2];                                                                                     \
        _Pragma("unroll") for (int qt = 0; qt < 2; qt++)                                                  \
          _Pragma("unroll") for (int j = 0; j < 8; j++) pf[qt][j] = (short)f2bf(st[qt][8 * s + j]);       \
        _Pragma("unroll") for (int dt = 0; dt < 2; dt++) {                                                \
          const u16* vp = cV + (dt * 32 + ql) * 72 + (ks) * 32 + 16 * s + 4 * hf;                         \
          s16x4 lo = *(const s16x4*)vp, hi = *(const s16x4*)(vp + 8);                                     \
          bf16x8 vf = __builtin_shufflevector(lo, hi, 0, 1, 2, 3, 4, 5, 6, 7);                            \
          _Pragma("unroll") for (int qt = 0; qt < 2; qt++) o[dt][qt] = MFMA(vf, pf[qt], o[dt][qt]);       \
        }                                                                                                 \
      }                                                                                                   \
      __builtin_amdgcn_sched_barrier(0);                                                                  \
    }
  if (late) { ATT_LOAD(1) }
  int cur3 = 0;
  for (int kt = 0; kt < 128; kt++) {
    const int nxt3 = (cur3 == 2) ? 0 : cur3 + 1;
    const u16* cK = sK + cur3 * 64 * 72;
    const u16* cV = sV + cur3 * 64 * 72;
    f32x16 st[2];
    if (!late) { if (kt + 1 < 128) { ATT_LOAD(kt + 1) } }
    ATT_QKEXP(0)
    if (late) {
      if (kt + 1 < 128) { ATT_STORE(nxt3) }
      __syncthreads();
      if (kt + 2 < 128) { ATT_LOAD(kt + 2) }
    }
    ATT_PV(0)
    ATT_QKEXP(1)
    ATT_PV(1)
    if (!late) {
      if (kt + 1 < 128) { ATT_STORE(nxt3) }
      __syncthreads();
    }
    cur3 = nxt3;
  }
  __syncthreads();
#undef ATT_LOAD
#undef ATT_STORE
#undef ATT_QKEXP
#undef ATT_PV
  const int te_ = opaque_vtid();
  const int lane_e = te_ & 63, wave_e = te_ >> 6, ql_e = lane_e & 31, hf_e = lane_e >> 5;
  u16* sO = (u16*)smem + wave_e * 64 * 72;
#pragma unroll
  for (int qt = 0; qt < 2; qt++) {
    float lt = ls[qt].x + ls[qt].y;
    lt += shx<32>(lt);
    const float inv = 1.f / lt;
#pragma unroll
    for (int dt = 0; dt < 2; dt++)
#pragma unroll
      for (int rq = 0; rq < 4; rq++) {
        int d = dt * 32 + 8 * rq + 4 * hf_e;
        uint2 pk; pk.x = pack2(o[dt][qt][rq * 4] * inv, o[dt][qt][rq * 4 + 1] * inv); pk.y = pack2(o[dt][qt][rq * 4 + 2] * inv, o[dt][qt][rq * 4 + 3] * inv);
        *(uint2*)(sO + (qt * 32 + ql_e) * 72 + d) = pk;
      }
  }
  __syncthreads();
  u16* dst = p.AO + ((long)b * 8192 + qb * 256 + wave_e * 64) * 512 + h * 64;
#pragma unroll 2
  for (int i = 0; i < 8; i++) {
    int unit = lane_e + 64 * i, q = unit >> 3, ch = unit & 7;
    *(uint4*)(dst + (long)q * 512 + ch * 8) = *(const uint4*)(sO + q * 72 + ch * 8);
  }
  __syncthreads();
}

DI void ph_attn(const P& p, int l, char* smem, const Xcd xc, const int vb) {
  const int tid = opaque_vtid();
  for (int base = xc.slot * 2; base < 64; base += xc.n * 2) {
    const int sl = base + vb;
    attn_item(p, l, ((xc.id >> 1) << 7) | ((xc.id & 1) << 6) | sl, smem, tid, sl * 2, vb != 0);
  }
}

DI void ph_branch(const P& p, int l, char* smem, int bid, int nb, const Xcd xc) {
  const int tid = opaque_tid();
  float* sC = (float*)smem;
  XCD_TILE_LOOP(64, 4, mt2, nt2) {
    f32x16 a1[4][2];
    zero_acc<4>(a1);
    gemm_main<4>(p.Y + (long)mt2 * 256 * 512, 512, p.WBF + ((long)l * 1024 + nt2 * 256) * 512, 512, 512, a1, smem, tid, j_);
#pragma unroll 1
    for (int q = 0; q < 4; q++) {
      const int mh = q >> 1, nh = q & 1, mt = mt2 * 2 + mh, nt = nt2 * 2 + nh;
      stage_q(a1, sC, tid, mh, nh);
#pragma unroll 1
      for (int unit = opaque_tid(); unit < 2048; unit += NTHR) {
        int row = unit >> 4, ch = unit & 15;
        const u16* gp = p.GATES + ((long)mt * 128 + row) * 2048 + nt * 128 + ch * 8;
        uint4 gf = *(const uint4*)gp, ga = *(const uint4*)(gp + 1024);
        float* sp = sC + row * 132 + ch * 8;
        float4 a = *(const float4*)sp, c = *(const float4*)(sp + 4);
        a.x *= bflo(gf.x) / fmaxf(bflo(ga.x), 1e-20f); a.y *= bfhi(gf.x) / fmaxf(bfhi(ga.x), 1e-20f);
        a.z *= bflo(gf.y) / fmaxf(bflo(ga.y), 1e-20f); a.w *= bfhi(gf.y) / fmaxf(bfhi(ga.y), 1e-20f);
        c.x *= bflo(gf.z) / fmaxf(bflo(ga.z), 1e-20f); c.y *= bfhi(gf.z) / fmaxf(bfhi(ga.z), 1e-20f);
        c.z *= bflo(gf.w) / fmaxf(bflo(ga.w), 1e-20f); c.w *= bfhi(gf.w) / fmaxf(bfhi(ga.w), 1e-20f);
        *(float4*)sp = a; *(float4*)(sp + 4) = c;
      }
      __syncthreads();
      unstage_q(a1, sC, tid, mh, nh);
    }
    gemm_main<4>(p.AO + (long)mt2 * 256 * 512, 512, p.WBA + ((long)l * 1024 + nt2 * 256) * 512, 512, 512, a1, smem, tid, j_);
#pragma unroll 1
    for (int q = 0; q < 4; q++) {
      const int mh = q >> 1, nh = q & 1, mt = mt2 * 2 + mh, nt = nt2 * 2 + nh;
      stage_q(a1, sC, tid, mh, nh);
#pragma unroll 1
      for (int unit = opaque_tid(); unit < 2048; unit += NTHR) {
        int row = unit >> 4, ch = unit & 15;
        uint4 ga = *(const uint4*)(p.GATES + ((long)mt * 128 + row) * 2048 + 1024 + nt * 128 + ch * 8);
        float4 a = *(const float4*)(sC + row * 132 + ch * 8), c = *(const float4*)(sC + row * 132 + ch * 8 + 4);
        uint4 o;
        o.x = pack2(a.x * fmaxf(bflo(ga.x), 1e-20f), a.y * fmaxf(bfhi(ga.x), 1e-20f));
        o.y = pack2(a.z * fmaxf(bflo(ga.y), 1e-20f), a.w * fmaxf(bfhi(ga.y), 1e-20f));
        o.z = pack2(c.x * fmaxf(bflo(ga.z), 1e-20f), c.y * fmaxf(bfhi(ga.z), 1e-20f));
        o.w = pack2(c.z * fmaxf(bflo(ga.w), 1e-20f), c.w * fmaxf(bfhi(ga.w), 1e-20f));
        *(uint4*)(p.MIXED + ((long)mt * 128 + row) * 1024 + nt * 128 + ch * 8) = o;
      }
      __syncthreads();
    }
  }
}

DI void ph_outproj(const P& p, int l, char* smem, int bid, int nb, const Xcd xc) {
  const int tid = opaque_tid();
  float* sC = (float*)smem;
  XCD_TILE_LOOP(64, 4, mt2, nt2) {
    f32x16 acc[4][2];
    zero_acc<4>(acc);
    gemm_main<4>(p.MIXED + (long)mt2 * 256 * 1024, 1024, p.WOUT + ((long)l * 1024 + nt2 * 256) * 1024, 1024, 1024, acc, smem, tid, j_);
#pragma unroll 1
    for (int q = 0; q < 4; q++) {
      const int mh = q >> 1, nh = q & 1, mt = mt2 * 2 + mh, nt = nt2 * 2 + nh;
      stage_q(acc, sC, tid, mh, nh);
#pragma unroll 1
      for (int unit = opaque_tid(); unit < 2048; unit += NTHR) {
        int row = unit >> 4, ch = unit & 15;
        long gi = ((long)mt * 128 + row) * 1024 + nt * 128 + ch * 8;
        float4 a = *(const float4*)(sC + row * 132 + ch * 8), c = *(const float4*)(sC + row * 132 + ch * 8 + 4);
        float4 xa = *(const float4*)(p.XS + gi), xc4 = *(const float4*)(p.XS + gi + 4);
        a.x += ALPHA * xa.x; a.y += ALPHA * xa.y; a.z += ALPHA * xa.z; a.w += ALPHA * xa.w;
        c.x += ALPHA * xc4.x; c.y += ALPHA * xc4.y; c.z += ALPHA * xc4.z; c.w += ALPHA * xc4.w;
        *(float4*)(p.out + gi) = a; *(float4*)(p.out + gi + 4) = c;
      }
      __syncthreads();
    }
  }
}

DI void ph_ln1(const P& p, int l, int bid, int nb) {
  const int tid = opaque_vtid(), lane = tid & 63, wave = tid >> 6;
  for (int row = bid * 4 + wave; row < T; row += nb * 4) {
    const float* src = p.out + (long)row * 1024;
    float v[16];
#pragma unroll
    for (int c = 0; c < 4; c++) { float4 t = *(const float4*)(src + (lane + 64 * c) * 4); v[c * 4] = t.x; v[c * 4 + 1] = t.y; v[c * 4 + 2] = t.z; v[c * 4 + 3] = t.w; }
    ln16_write(v, p.ln1g + l * 1024, p.ln1b + l * 1024, p.XS + (long)row * 1024, p.XB + (long)row * 1024, lane);
  }
}

DI void ph_peerq(const P& p, int l, char* smem, int bid, int nb, const Xcd xc) {
  const int tid = opaque_tid();
  float* sC = (float*)smem;
  XCD_TILE_LOOP(64, 8, mt2, nt2) {
    f32x16 acc[4][2];
    zero_acc<4>(acc);
    gemm_main<4>(p.XB + (long)mt2 * 256 * 1024, 1024, p.WQ + ((long)l * 2048 + nt2 * 256) * 1024, 1024, 1024, acc, smem, tid, j_);
#pragma unroll 1
    for (int q = 0; q < 4; q++) {
      const int mh = q >> 1, nh = q & 1, mt = mt2 * 2 + mh, nt = nt2 * 2 + nh;
      stage_q(acc, sC, tid, mh, nh);
#pragma unroll 1
      for (int unit = opaque_tid(); unit < 2048; unit += NTHR) {
        int row = unit >> 4, ch = unit & 15;
        float4 a = *(const float4*)(sC + row * 132 + ch * 8), c = *(const float4*)(sC + row * 132 + ch * 8 + 4);
        uint4 o; o.x = pack2(a.x, a.y); o.y = pack2(a.z, a.w); o.z = pack2(c.x, c.y); o.w = pack2(c.z, c.w);
        *(uint4*)(p.QP + ((long)mt * 128 + row) * 2048 + nt * 128 + ch * 8) = o;
      }
      __syncthreads();
    }
  }
}

DI int okey(float v) { int b = __float_as_int(v); return b ^ ((b >> 31) & 0x7fffffff); }
DI float okey_val(int k) { return __int_as_float(k ^ ((k >> 31) & 0x7fffffff)); }
DI int med3i(int a, int b, int c) { int r; asm("v_med3_i32 %0, %1, %2, %3" : "=v"(r) : "v"(a), "v"(b), "v"(c)); return r; }
DI void ins16(int (&L)[16], int x) {
#pragma unroll
  for (int i = 15; i > 0; i--) L[i] = med3i(L[i - 1], L[i], x);
  L[0] = max(L[0], x);
}

DI void peer_finish_token(const P& p, int l, bool last, const long tok, f32x2 (&acc2)[8], float csum, const int lane) {
      float acc[16];
#pragma unroll
      for (int i = 0; i < 8; i++) { acc[2 * i] = acc2[i].x; acc[2 * i + 1] = acc2[i].y; }
      csum *= 128.f;
      const float* xs = p.XS + tok * 1024 + lane * 16;
      float y[16];
#pragma unroll
      for (int c = 0; c < 4; c++) {
        float4 a = *(const float4*)(xs + c * 4);
        y[c * 4 + 0] = ALPHA * a.x + acc[c * 4 + 0] - csum; y[c * 4 + 1] = ALPHA * a.y + acc[c * 4 + 1] - csum;
        y[c * 4 + 2] = ALPHA * a.z + acc[c * 4 + 2] - csum; y[c * 4 + 3] = ALPHA * a.w + acc[c * 4 + 3] - csum;
      }
      float s = 0.f;
#pragma unroll
      for (int i = 0; i < 16; i++) s += y[i];
      float mu = wave_sum(s) * (1.f / 1024.f);
      float q = 0.f;
#pragma unroll
      for (int i = 0; i < 16; i++) { float dd = y[i] - mu; q += dd * dd; }
      float rstd = rsqrtf(wave_sum(q) * (1.f / 1024.f) + 1e-5f);
      const float* g = p.ln2g + l * 1024;
      const float* bt = p.ln2b + l * 1024;
      float* dstf;
      if (last) {
        int b = (int)(tok >> 13), u = (int)(tok & 8191);
        int sact = (u & 127) * 64 + (u >> 7);
        dstf = p.out + ((long)b * 8192 + sact) * 1024;
      } else dstf = p.XS + tok * 1024;
      {
        const int e0 = lane * 16;
        float o[16];
#pragma unroll
        for (int c = 0; c < 4; c++) {
          float4 g0 = *(const float4*)(g + e0 + c * 4), b0 = *(const float4*)(bt + e0 + c * 4);
          o[c * 4 + 0] = (y[c * 4 + 0] - mu) * rstd * g0.x + b0.x; o[c * 4 + 1] = (y[c * 4 + 1] - mu) * rstd * g0.y + b0.y;
          o[c * 4 + 2] = (y[c * 4 + 2] - mu) * rstd * g0.z + b0.z; o[c * 4 + 3] = (y[c * 4 + 3] - mu) * rstd * g0.w + b0.w;
          *(float4*)(dstf + e0 + c * 4) = make_float4(o[c * 4], o[c * 4 + 1], o[c * 4 + 2], o[c * 4 + 3]);
        }
        if (!last) {
          uint4 pk; pk.x = pack2(o[0], o[1]); pk.y = pack2(o[2], o[3]); pk.z = pack2(o[4], o[5]); pk.w = pack2(o[6], o[7]);
          *(uint4*)(p.XB + tok * 1024 + e0) = pk;
          pk.x = pack2(o[8], o[9]); pk.y = pack2(o[10], o[11]); pk.z = pack2(o[12], o[13]); pk.w = pack2(o[14], o[15]);
          *(uint4*)(p.XB + tok * 1024 + e0 + 8) = pk;
        }
      }
}

DI void ph_peer(const P& p, int l, char* smem, int bid, int nb, bool last) {
  const int tid = opaque_vtid(), lane = tid & 63, wave = tid >> 6;
  const int tl = lane & 31, hf = lane >> 5;
  int* sel_e = (int*)smem;
  float* sel_w = (float*)(smem + 16384);
  unsigned char* sidx = (unsigned char*)(smem + 32768);
  float* scoef = (float*)(smem + 32768 + 4096);
  const u16* SKl = p.SK + (long)l * 8 * 2 * 128 * 128;
  const unsigned char* Ul = p.U8 + (long)l * 16384 * 1024;
  const unsigned char* Vl = p.V8 + (long)l * 16384 * 1024;
  const float* SUl = p.SU + l * 16384;
  const float* SVl = p.SV + l * 16384;
  for (int tk = bid; tk < T / 32; tk += nb) {
    const int t0 = tk * 32;
    const int tidr_ = opaque_vtid();
    const int lane = tidr_ & 63, wave = tidr_ >> 6, tl = lane & 31, hf = lane >> 5;
    __syncthreads();
    for (int hi = 0; hi < 2; hi++) {
      const int hh = wave + 4 * hi;
      int L1[16], L2[16];
#pragma unroll
      for (int half = 0; half < 2; half++) {
        f32x16 acc[4];
#pragma unroll
        for (int mt = 0; mt < 4; mt++)
#pragma unroll
          for (int r = 0; r < 16; r++) acc[mt][r] = 0.f;
        const u16* qrow = p.QP + (long)(t0 + tl) * 2048 + hh * 256 + half * 128 + hf * 8;
        const u16* krow = SKl + ((long)(hh * 2 + half) * 128 + tl) * 128 + hf * 8;
#pragma unroll
        for (int kd = 0; kd < 8; kd++) {
          bf16x8 bq = *(const bf16x8*)(qrow + kd * 16);
#pragma unroll
          for (int mt = 0; mt < 4; mt++) {
            bf16x8 ak = *(const bf16x8*)(krow + (long)mt * 32 * 128 + kd * 16);
            acc[mt] = MFMA(ak, bq, acc[mt]);
          }
          if (kd == 3) __builtin_amdgcn_sched_barrier(0);
        }
        int L[16];
#pragma unroll
        for (int i = 0; i < 16; i++) L[i] = (int)0x80000000;
#pragma unroll
        for (int mt = 0; mt < 4; mt++)
#pragma unroll
          for (int r = 0; r < 16; r++) {
            int key = mt * 32 + 8 * (r >> 2) + 4 * hf + (r & 3);
            int k = (okey(acc[mt][r]) & ~0x7f) | (127 - key);
            ins16(L, k);
          }
        int S[16];
#pragma unroll
        for (int i = 0; i < 16; i++) S[i] = L[i];
#pragma unroll
        for (int i = 0; i < 16; i++) { int pv = shxi<32>(S[i]); ins16(L, pv); }
        if (half == 0) {
#pragma unroll
          for (int i = 0; i < 16; i++) L1[i] = L[i];
        } else {
#pragma unroll
          for (int i = 0; i < 16; i++) L2[i] = L[i];
        }
      }
      float v1[16], v2[16];
#pragma unroll
      for (int i = 0; i < 16; i++) { v1[i] = okey_val(L1[i] & ~0x7f); v2[i] = okey_val(L2[i] & ~0x7f); }
      unsigned char* myidx = sidx + (wave * 32 + tl) * 32;
      if (hf == 0) {
#pragma unroll
        for (int i = 0; i < 16; i++) { myidx[i] = (unsigned char)(127 - (L1[i] & 0x7f)); myidx[16 + i] = (unsigned char)(127 - (L2[i] & 0x7f)); }
      }
      int C[16];
#pragma unroll
      for (int i = 0; i < 16; i++) C[i] = (int)0x80000000;
#pragma unroll
      for (int i = 0; i < 16; i++)
#pragma unroll
        for (int j = 0; j < 16; j++)
          if ((i + 1) * (j + 1) <= 16) {
            int k = (okey(v1[i] + v2[j]) & ~0xff) | (255 - (i * 16 + j));
            ins16(C, k);
          }
      float sv[16];
#pragma unroll
      for (int r = 0; r < 16; r++) sv[r] = okey_val(C[r] & ~0xff);
      float den = 0.f;
      {
        float top = sv[0];
#pragma unroll
        for (int r = 0; r < 16; r++) { sv[r] = __expf(sv[r] - top); den += sv[r]; }
      }
      float rden = 1.f / den;
#pragma unroll
      for (int r = 0; r < 16; r++) {
        if ((r >> 3) == hf) {
          int pos = 255 - (C[r] & 0xff);
          int i1 = myidx[pos >> 4], i2 = myidx[16 + (pos & 15)];
          sel_e[tl * 128 + hh * 16 + r] = i1 * 128 + i2;
          sel_w[tl * 128 + hh * 16 + r] = sv[r] * rden;
        }
      }
    }
    __syncthreads();
    int* nlo_tab = (int*)sidx;
    for (int tt = wave; tt < 32; tt += 4) {
      const int e0_ = sel_e[tt * 128 + lane], e1_ = sel_e[tt * 128 + lane + 64];
      const float w0_ = sel_w[tt * 128 + lane], w1_ = sel_w[tt * 128 + lane + 64];
      const bool lo0 = e0_ < 8192, lo1 = e1_ < 8192;
      const unsigned long long m0 = __ballot(lo0), m1 = __ballot(lo1);
      const unsigned long long lt = (1ull << lane) - 1ull;
      const int c0 = __popcll(m0), c1 = __popcll(m1), nlo = c0 + c1;
      const int p0 = lo0 ? __popcll(m0 & lt) : nlo + __popcll(~m0 & lt);
      const int p1 = lo1 ? c0 + __popcll(m1 & lt) : nlo + (64 - c0) + __popcll(~m1 & lt);
      __builtin_amdgcn_wave_barrier();
      sel_e[tt * 128 + p0] = e0_; sel_e[tt * 128 + p1] = e1_;
      sel_w[tt * 128 + p0] = w0_; sel_w[tt * 128 + p1] = w1_;
      if (lane == 0) nlo_tab[tt] = nlo;
    }
    __builtin_amdgcn_wave_barrier();
    {
    const int tidg_ = opaque_vtid();
    const int lane = tidg_ & 63, wave = tidg_ >> 6;
    const int sub = lane & 15, grp = lane >> 4;
#pragma unroll 1
    for (int upass = 0; upass < 2; upass++)
    for (int tt = wave; tt < 32; tt += 4) {
      const long tok = t0 + tt;
      const int ssp = ((nlo_tab[tt] + 8) >> 4) << 1;
      const int s_beg = upass ? ssp : 0, s_end = upass ? 16 : ssp;
      f32x2 xf[32];
      float sx = 0.f;
#pragma unroll
      for (int c = 0; c < 4; c++) {
#pragma unroll
        for (int h2 = 0; h2 < 2; h2++) {
          uint4 xr = *(const uint4*)(p.XB + tok * 1024 + (sub + 16 * c) * 16 + h2 * 8);
          f32x2* xp = xf + c * 8 + h2 * 4;
          xp[0] = f32x2{bflo(xr.x), bfhi(xr.x)}; xp[1] = f32x2{bflo(xr.y), bfhi(xr.y)};
          xp[2] = f32x2{bflo(xr.z), bfhi(xr.z)}; xp[3] = f32x2{bflo(xr.w), bfhi(xr.w)};
        }
      }
#pragma unroll
      for (int i = 0; i < 32; i++) sx += xf[i].x + xf[i].y;
      sx *= 128.f;
      float dk0 = 0.f, dk1 = 0.f;
      u32x4 bufA[8], bufB[8];
#define ISSUE_U(buf, st)                                                                 \
      _Pragma("unroll") for (int j = 0; j < 2; j++) {                                    \
        const int eidx_ = sel_e[tt * 128 + ((st) * 2 + j) * 4 + grp];                    \
        const unsigned char* ur_ = Ul + (long)eidx_ * 1024 + sub * 16;                   \
        _Pragma("unroll") for (int c = 0; c < 4; c++) buf[j * 4 + c] = *(const u32x4*)(ur_ + c * 256); \
      }
#define COMPUTE_U(buf, st)                                                               \
      _Pragma("unroll") for (int j = 0; j < 2; j++) {                                    \
        f32x2 d2 = f32x2{-sx, 0.f};                                                      \
        _Pragma("unroll") for (int c = 0; c < 4; c++)                                    \
          _Pragma("unroll") for (int w = 0; w < 4; w++) {                                \
            const unsigned q = buf[j * 4 + c][w];                                        \
            d2 += f32x2{(float)(q & 0xffu), (float)((q >> 8) & 0xffu)} * xf[c * 8 + w * 2];      \
            d2 += f32x2{(float)((q >> 16) & 0xffu), (float)(q >> 24)} * xf[c * 8 + w * 2 + 1];   \
          }                                                                              \
        float d = d2.x + d2.y;                                                           \
        d += shx<1>(d); d += shx<2>(d); d += shx<4>(d); d += shx<8>(d); \
        const int it_ = (st) * 2 + j;                                                    \
        if (sub == (it_ & 15)) { if (it_ < 16) dk0 = d; else dk1 = d; }                  \
        __builtin_amdgcn_sched_barrier(0);                                               \
      }
      if (s_beg < s_end) { ISSUE_U(bufA, s_beg) }
      for (int st = s_beg; st < s_end; st += 2) {
        ISSUE_U(bufB, st + 1)
        COMPUTE_U(bufA, st)
        if (st + 2 < s_end) { ISSUE_U(bufA, st + 2) }
        COMPUTE_U(bufB, st + 1)
      }
      {
        const int e0 = sub * 4 + grp, e1 = (16 + sub) * 4 + grp;
        const bool in0 = (sub >= 2 * s_beg) && (sub < 2 * s_end), in1 = (16 + sub >= 2 * s_beg) && (16 + sub < 2 * s_end);
        const int x0 = sel_e[tt * 128 + e0], x1 = sel_e[tt * 128 + e1];
        float d0 = dk0 * SUl[x0], d1 = dk1 * SUl[x1];
        float a0 = 0.5f * d0 * (1.f + erff(d0 * 0.7071067811865476f));
        float a1 = 0.5f * d1 * (1.f + erff(d1 * 0.7071067811865476f));
        if (in0) sel_w[tt * 128 + e0] = a0 * sel_w[tt * 128 + e0] * SVl[x0];
        if (in1) sel_w[tt * 128 + e1] = a1 * sel_w[tt * 128 + e1] * SVl[x1];
      }
    }
#pragma unroll 1
    for (int hsel = 0; hsel < 2; hsel++) {
      f32x2 accT[4][8];
      float csumT[4];
#pragma unroll
      for (int ti = 0; ti < 4; ti++) {
        csumT[ti] = 0.f;
#pragma unroll
        for (int i = 0; i < 8; i++) accT[ti][i] = f32x2{0.f, 0.f};
      }
#define ISSUE_V(buf, tt_, st)                                                            \
      _Pragma("unroll") for (int j = 0; j < 8; j++) {                                    \
        const int eidx_ = __builtin_amdgcn_readfirstlane(sel_e[(tt_) * 128 + (st) * 8 + j]); \
        buf[j] = *(const u32x4*)(Vl + (long)eidx_ * 1024 + (unsigned)(lane * 16));       \
      }
#define COMPUTE_V(buf, ti, tt_, st)                                                      \
      _Pragma("unroll") for (int j = 0; j < 8; j++) {                                    \
        const float c_ = sel_w[(tt_) * 128 + (st) * 8 + j];                              \
        csumT[ti] += c_;                                                                 \
        const f32x2 c2 = f32x2{c_, c_};                                                  \
        _Pragma("unroll") for (int w = 0; w < 4; w++) {                                  \
          const unsigned q = buf[j][w];                                                  \
          accT[ti][w * 2] += c2 * f32x2{(float)(q & 0xffu), (float)((q >> 8) & 0xffu)};  \
          accT[ti][w * 2 + 1] += c2 * f32x2{(float)((q >> 16) & 0xffu), (float)(q >> 24)}; \
        }                                                                                \
        if (j & 1) __builtin_amdgcn_sched_barrier(0);                                    \
      }
#pragma unroll 1
      for (int vpass = 0; vpass < 2; vpass++) {
#pragma unroll
        for (int ti = 0; ti < 4; ti++) {
          const int tt = wave + 4 * (hsel * 4 + ti);
          const int ssp = ((nlo_tab[tt] + 8) >> 4) << 1;
          const int c_beg = vpass ? ssp : 0, c_end = vpass ? 16 : ssp;
          u32x4 bufA[8], bufB[8];
          if (c_beg < c_end) { ISSUE_V(bufA, tt, c_beg) }
#pragma unroll 1
          for (int st = c_beg; st < c_end; st += 2) {
            ISSUE_V(bufB, tt, st + 1)
            COMPUTE_V(bufA, ti, tt, st)
            if (st + 2 < c_end) { ISSUE_V(bufA, tt, st + 2) }
            COMPUTE_V(bufB, ti, tt, st + 1)
          }
        }
      }
      peer_finish_token(p, l, last, t0 + wave + 4 * (hsel * 4 + 0), accT[0], csumT[0], lane);
      peer_finish_token(p, l, last, t0 + wave + 4 * (hsel * 4 + 1), accT[1], csumT[1], lane);
      peer_finish_token(p, l, last, t0 + wave + 4 * (hsel * 4 + 2), accT[2], csumT[2], lane);
      peer_finish_token(p, l, last, t0 + wave + 4 * (hsel * 4 + 3), accT[3], csumT[3], lane);
    }
    }
  }
}


#define XB_TMO      128
#define XB_XCNT(j)  (256  + 64 * (j))
#define XB_XSUB(j)  (1280 + 64 * (j))
#define XB_XGEN(j)  (2304 + 64 * (j))
#define XB_TOP      3328
#define XB_TOPGEN   3392
#define XB_CENSUS   3456
#define XCD_BAR_WORDS 3472
#define XB_SPIN_CAP (1u << 22)
DI unsigned xb_ld(unsigned* p) { return __hip_atomic_load(p, __ATOMIC_RELAXED, __HIP_MEMORY_SCOPE_AGENT); }
DI unsigned xb_add(unsigned* p, unsigned v) { return __hip_atomic_fetch_add(p, v, __ATOMIC_RELAXED, __HIP_MEMORY_SCOPE_AGENT); }
DI unsigned xb_xcc_id() { return (unsigned)__builtin_amdgcn_s_getreg((3 << 11) | 20) & 0xFu; }
#define XB_SPIN(cond, bar) do { unsigned _sp = 0; while (cond) { __builtin_amdgcn_s_sleep(1); \
    if ((++_sp & 255u) == 0u) { if (xb_ld(&(bar)[XB_TMO])) break; if (_sp > XB_SPIN_CAP) { atomicAdd(&(bar)[XB_TMO], 1u); break; } } } } while (0)
struct XcdBarrier { unsigned* bar; unsigned x; volatile LAS unsigned* st; };
DI volatile LAS unsigned* xb_state() { __shared__ uint4 xb_words_; return (volatile LAS unsigned*)&xb_words_; }
DI XcdBarrier xcd_barrier_post(unsigned* bar, volatile LAS unsigned* st) {
  XcdBarrier b; b.bar = bar; b.x = xb_xcc_id(); b.st = st;
  if (threadIdx.x == 0) (void)xb_add(&bar[XB_XCNT(b.x)], 1u);
  return b;
}
DI void xcd_barrier_complete(unsigned* bar, unsigned x, unsigned& nloc, unsigned& nx) {
  const unsigned G = gridDim.x;
  unsigned sum, cnt, mine, sp = 0u;
  for (;;) {
    sum = 0u; cnt = 0u; mine = 0u;
#pragma unroll
    for (unsigned j = 0; j < 16; ++j) { const unsigned c = xb_ld(&bar[XB_XCNT(j)]); sum += c; cnt += (c > 0u) ? 1u : 0u; mine = (j == x) ? c : mine; }
    if (sum == G) break;
    __builtin_amdgcn_s_sleep(1);
    if ((++sp & 255u) == 0u) { if (xb_ld(&bar[XB_TMO])) break; if (sp > XB_SPIN_CAP) { atomicAdd(&bar[XB_TMO], 1u); break; } }
  }
  nloc = mine > 0u ? mine : 1u; nx = cnt > 0u ? cnt : 1u;
}
DI void xcd_barrier(unsigned* bar_, volatile LAS unsigned* st_) {
  XcdBarrier b; b.bar = bar_; b.st = st_; b.x = xb_xcc_id();
  asm volatile("s_waitcnt vmcnt(0)" ::: "memory");
  __syncthreads();
  if (opaque_tid() == 0) {
    unsigned* bar = b.bar;
    __builtin_amdgcn_s_waitcnt(0);
    unsigned nloc = b.st[0], nx = b.st[1];
    if (nloc == 0u) { xcd_barrier_complete(bar, b.x, nloc, nx); b.st[0] = nloc; b.st[1] = nx; }
    const unsigned old = xb_add(&bar[XB_XSUB(b.x)], 1u);
    const unsigned gen = old / nloc;
    if (old + 1u == (gen + 1u) * nloc) {
      __builtin_amdgcn_fence(__ATOMIC_RELEASE, "agent");
      asm volatile("s_waitcnt vmcnt(0)" ::: "memory");
      const unsigned og = xb_add(&bar[XB_TOP], 1u);
      const unsigned tg = og / nx;
      if (og + 1u == (tg + 1u) * nx) xb_add(&bar[XB_TOPGEN], 1u);
      else XB_SPIN(xb_ld(&bar[XB_TOPGEN]) == tg, bar);
      __builtin_amdgcn_fence(__ATOMIC_ACQUIRE, "agent");
      xb_add(&bar[XB_XGEN(b.x)], 1u);
      asm volatile("s_waitcnt vmcnt(0)" ::: "memory");
    } else {
      XB_SPIN(xb_ld(&bar[XB_XGEN(b.x)]) == gen, bar);
      __builtin_amdgcn_fence(__ATOMIC_ACQUIRE, "agent");
      asm volatile("s_waitcnt vmcnt(0)" ::: "memory");
    }
  }
  __syncthreads();
}

#ifndef REP
#define REP -1
#endif
#define BAR() xcd_barrier(p.BAR, xb_state())
#define RUNPH(k, call) do { call; if (REP == (k)) { BAR(); call; } } while (0)
__global__ void __launch_bounds__(NTHR, 2) mega_kernel(P p) {
  extern __shared__ __attribute__((aligned(1024))) char smem[];
  __shared__ int xc_sh[2];
  const int bid = blockIdx.x, nb = gridDim.x;
  if (threadIdx.x == 0) { volatile LAS unsigned* st = xb_state(); st[0] = 0u; st[1] = 0u; st[2] = 0u; st[3] = 0u; }
  if ((threadIdx.x & 63) == 0) wmap()[hw_slot()] = (int)(threadIdx.x >> 6);
  __syncthreads();
  (void)xcd_barrier_post(p.BAR, xb_state());
  if (threadIdx.x == 0) { const unsigned x = xb_xcc_id() & 7u; xc_sh[0] = (int)x; xc_sh[1] = (int)xb_add(&p.BAR[XB_CENSUS + x], 1u); }
  __syncthreads();
  const int vb = __builtin_amdgcn_readfirstlane((int)threadIdx.x >> 8);
  const int vbid = bid * 2 + vb, vnb = nb * 2;
  char* vsmem = smem + vb * VSMEM;
  RUNPH(0, ph_prep(p, vsmem, vbid, vnb));
  BAR();
  Xcd xc;
  xc.id = __builtin_amdgcn_readfirstlane(xc_sh[0]); xc.slot = __builtin_amdgcn_readfirstlane(xc_sh[1]);
  xc.n = __builtin_amdgcn_readfirstlane((int)xb_ld(&p.BAR[XB_CENSUS + xc.id]));
#pragma unroll 1
  for (int l = 0; l < 2; l++) {
    RUNPH(1, ph_inproj(p, l, smem, bid, nb, xc));
    BAR();
    ph_fftA(p, smem, bid, nb);
    RUNPH(2, ph_attn(p, l, vsmem, xc, vb));
    BAR();
    RUNPH(3, ph_fftC(p, smem, bid, nb));
    BAR();
    RUNPH(4, ph_branch(p, l, smem, bid, nb, xc));
    BAR();
    RUNPH(5, ph_outproj(p, l, smem, bid, nb, xc));
    BAR();
    RUNPH(6, ph_ln1(p, l, vbid, vnb));
    BAR();
    RUNPH(7, ph_peerq(p, l, smem, bid, nb, xc));
    BAR();
    if (REP == 8) { ph_peer(p, l, vsmem, vbid, vnb, true); BAR(); }
    ph_peer(p, l, vsmem, vbid, vnb, l == 1);
    if (l == 0) BAR();
  }
}

extern "C" void kernel_launch(void* const* d_in, const int* in_sizes, int n_in, void* d_out, int out_size,
                              void* d_ws, size_t ws_size, hipStream_t stream) {
  P p{};
  p.x = (const float*)d_in[0]; p.ln0g = (const float*)d_in[1]; p.ln0b = (const float*)d_in[2];
  p.w_in = (const float*)d_in[3]; p.b_gate = (const float*)d_in[4]; p.qng = (const float*)d_in[5]; p.kng = (const float*)d_in[6];
  p.w_bf = (const float*)d_in[7]; p.w_ba = (const float*)d_in[8]; p.w_out = (const float*)d_in[9];
  p.ln1g = (const float*)d_in[10]; p.ln1b = (const float*)d_in[11]; p.w_q = (const float*)d_in[12]; p.sk = (const float*)d_in[13];
  p.pu = (const float*)d_in[14]; p.pv = (const float*)d_in[15]; p.ln2g = (const float*)d_in[16]; p.ln2b = (const float*)d_in[17];
  p.out = (float*)d_out;
  char* w = (char*)d_ws;
  size_t off = 0;
  auto take = [&](size_t bytes) { char* r = w + off; off += (bytes + 255) & ~(size_t)255; return r; };
  p.WIN = (u16*)take((size_t)2 * 3328 * 1024 * 2);
  p.WBF = (u16*)take((size_t)2 * 1024 * 512 * 2);
  p.WBA = (u16*)take((size_t)2 * 1024 * 512 * 2);
  p.WOUT = (u16*)take((size_t)2 * 1024 * 1024 * 2);
  p.WQ = (u16*)take((size_t)2 * 2048 * 1024 * 2);
  p.SK = (u16*)take((size_t)2 * 8 * 2 * 128 * 128 * 2);
  p.U8 = (unsigned char*)take((size_t)2 * 16384 * 1024);
  p.V8 = (unsigned char*)take((size_t)2 * 16384 * 1024);
  p.SU = (float*)take((size_t)2 * 16384 * 4);
  p.SV = (float*)take((size_t)2 * 16384 * 4);
  p.D256 = (u16*)take(256 * 256 * 2);
  p.C64 = (u16*)take(64 * 128 * 2);
  p.TW = (float2*)take(128 * 64 * 8);
  p.ROPE = (float2*)take(128 * 16 * 8);
  p.XS = (float*)take((size_t)T * 1024 * 4);
  p.XB = (u16*)take((size_t)T * 1024 * 2);
  p.ZT = (u16*)take((size_t)33280 * 256 * 2);
  p.GP = (u16*)take((size_t)66560 * 128 * 2);
  p.Y = (u16*)take((size_t)T * 512 * 2);
  p.Q = (u16*)take((size_t)T * 512 * 2);
  p.K = (u16*)take((size_t)T * 128 * 2);
  p.VT = (u16*)take((size_t)T * 128 * 2);
  p.AO = (u16*)take((size_t)T * 512 * 2);
  p.GATES = (u16*)take((size_t)T * 2048 * 2);
  p.QP = p.GATES;
  p.MIXED = (u16*)take((size_t)T * 1024 * 2);
  p.BAR = (unsigned*)take(XCD_BAR_WORDS * 4);
  if (off > ws_size) { fprintf(stderr, "workspace too small: need %zu have %zu\n", off, ws_size); return; }

  static int grid_blocks = 0;
  if (!grid_blocks) {
    int dev = 0, cus = 0, per_cu = 0;
    (void)hipGetDevice(&dev);
    (void)hipDeviceGetAttribute(&cus, hipDeviceAttributeMultiprocessorCount, dev);
    (void)hipFuncSetAttribute((const void*)mega_kernel, hipFuncAttributeMaxDynamicSharedMemorySize, SMEM_BYTES);
    (void)hipOccupancyMaxActiveBlocksPerMultiprocessor(&per_cu, mega_kernel, NTHR, SMEM_BYTES);
    if (per_cu < 1) per_cu = 1;
    grid_blocks = cus;
  }
  (void)hipMemsetAsync(p.BAR, 0, XCD_BAR_WORDS * 4, stream);
  void* args[] = {&p};
  hipError_t e = hipLaunchCooperativeKernel((void*)mega_kernel, dim3(grid_blocks), dim3(NTHR), args, SMEM_BYTES, stream);
  if (e != hipSuccess) fprintf(stderr, "cooperative launch failed: %s (grid %d)\n", hipGetErrorString(e), grid_blocks);
}
```

```cpp
#include <hip/hip_runtime.h>
#include <hip/hip_cooperative_groups.h>
#include <cstdio>
namespace cg = cooperative_groups;


typedef unsigned short u16;
using bf16x8 = __attribute__((ext_vector_type(8))) short;
using s16x4  = __attribute__((ext_vector_type(4))) short;
using f32x16 = __attribute__((ext_vector_type(16))) float;
using u32x4  = __attribute__((ext_vector_type(4))) unsigned;
using f32x2  = __attribute__((ext_vector_type(2))) float;
#define DI __device__ __forceinline__
#define MFMA(a, b, c) __builtin_amdgcn_mfma_f32_32x32x16_bf16((a), (b), (c), 0, 0, 0)

constexpr int T = 16384;
constexpr float ALPHA = 1.4142135623730951f;
constexpr int NTHR = 512;
constexpr int VSMEM = 73728;
constexpr int SMEM_BYTES = 2 * VSMEM;

struct P {
  const float *x, *ln0g, *ln0b, *w_in, *b_gate, *qng, *kng, *w_bf, *w_ba, *w_out, *ln1g, *ln1b, *w_q, *sk, *pu, *pv, *ln2g, *ln2b;
  float* out;
  u16 *WIN, *WBF, *WBA, *WOUT, *WQ, *SK, *D256, *C64;
  float2 *TW, *ROPE;
  float* XS;
  u16 *XB, *ZT, *GP, *Y, *Q, *K, *VT, *AO, *GATES, *MIXED, *QP;
  unsigned* BAR;
  unsigned char *U8, *V8;
  float *SU, *SV;
};

DI u16 f2bf(float f) { __bf16 h = (__bf16)f; return __builtin_bit_cast(u16, h); }
DI float bf2f(u16 h) { return __uint_as_float(((unsigned)h) << 16); }
DI unsigned pack2(float a, float b) { return (unsigned)f2bf(a) | ((unsigned)f2bf(b) << 16); }
DI float bflo(unsigned u) { return __uint_as_float(u << 16); }
DI float bfhi(unsigned u) { return __uint_as_float(u & 0xffff0000u); }
#define LAS __attribute__((address_space(3)))
DI int hw_slot() { return __builtin_amdgcn_s_getreg((5 << 11) | 4) & 63; }
DI volatile LAS int* wmap() { __shared__ int wm_[64]; return (volatile LAS int*)wm_; }
DI int lane_id() { int l; asm volatile("v_mbcnt_lo_u32_b32 %0, -1, 0\n\tv_mbcnt_hi_u32_b32 %0, -1, %0" : "=&v"(l)); return l; }
DI int opaque_tid() { int w = wmap()[hw_slot()]; int t = (w << 6) | lane_id(); asm volatile("" : "+v"(t)); return t; }
DI int opaque_vtid() { return opaque_tid() & 255; }
template <int M> DI int shxi(int v) {
  if constexpr (M < 32) return __builtin_amdgcn_ds_swizzle(v, (M << 10) | 0x1f);
  else { int a = (lane_id() ^ 32) << 2; asm volatile("" : "+v"(a)); return __builtin_amdgcn_ds_bpermute(a, v); }
}
template <int M> DI float shx(float v) { return __int_as_float(shxi<M>(__float_as_int(v))); }
DI float wave_sum(float v) {
  v += shx<32>(v); v += shx<16>(v); v += shx<8>(v); v += shx<4>(v); v += shx<2>(v); v += shx<1>(v);
  return v;
}

template <int MT>
DI void gemm_main(const u16* __restrict__ A, long lda, const u16* __restrict__ B, long ldb, int K,
                  f32x16 (&acc)[MT][2], char* smem, const int  , const int rot = 0) {
  constexpr int STAGE = (64 * MT + 256) * 72;
  u16* s0 = (u16*)smem;
  const int tid = opaque_tid();
  const int lane = tid & 63, wave = tid >> 6;
  const int wm = wave >> 2, wn = wave & 3;
  const int lr = tid >> 3, lc = (tid & 7) * 8;
  const u16* Ap = A + (long)lr * lda + lc;
  const u16* Bp = B + (long)lr * ldb + lc;
  u32x4 ra[MT], rb[4];
  const int nk = K >> 6;
#define G_LOAD(kt)                                                                                      \
  _Pragma("unroll") for (int c = 0; c < MT; c++) ra[c] = *(const u32x4*)(Ap + (long)(64 * c) * lda + (((kt) + rot) & (nk - 1)) * 64); \
  _Pragma("unroll") for (int c = 0; c < 4; c++) rb[c] = *(const u32x4*)(Bp + (long)(64 * c) * ldb + (((kt) + rot) & (nk - 1)) * 64);
#define G_STORE(st)                                                                                     \
  { u16* sA_ = s0 + (st) * STAGE; u16* sB_ = sA_ + 64 * MT * 72;                                        \
    _Pragma("unroll") for (int c = 0; c < MT; c++) *(u32x4*)(sA_ + (lr + 64 * c) * 72 + lc) = ra[c];    \
    _Pragma("unroll") for (int c = 0; c < 4; c++) *(u32x4*)(sB_ + (lr + 64 * c) * 72 + lc) = rb[c]; }
#define G_COMPUTE(st)                                                                                   \
  { const u16* sA_ = s0 + (st) * STAGE; const u16* sB_ = sA_ + 64 * MT * 72;                            \
    _Pragma("unroll") for (int kk = 0; kk < 4; kk++) {                                                  \
      bf16x8 af[MT], bfr[2];                                                                            \
      _Pragma("unroll") for (int i = 0; i < MT; i++) af[i] = *(const bf16x8*)(sA_ + (wm * 32 * MT + i * 32 + (lane & 31)) * 72 + kk * 16 + (lane >> 5) * 8); \
      _Pragma("unroll") for (int j = 0; j < 2; j++) bfr[j] = *(const bf16x8*)(sB_ + (wn * 64 + j * 32 + (lane & 31)) * 72 + kk * 16 + (lane >> 5) * 8);     \
      _Pragma("unroll") for (int i = 0; i < MT; i++)                                                    \
        _Pragma("unroll") for (int j = 0; j < 2; j++) acc[i][j] = MFMA(af[i], bfr[j], acc[i][j]);       \
      if (MT > 2) __builtin_amdgcn_sched_barrier(0);                                                    \
    } }
  G_LOAD(0)
  __syncthreads();
  G_STORE(0)
  G_LOAD((1 < nk ? 1 : 0))
  __syncthreads();
  const bool late = __builtin_amdgcn_readfirstlane(wave) >= 4;
  for (int t = 0; t < nk; t++) {
    if (!late) {
      if (t + 1 < nk) { G_STORE((t + 1) & 1) }
      if (t + 2 < nk) { G_LOAD(t + 2) }
    }
    __builtin_amdgcn_s_setprio(1);
    G_COMPUTE(t & 1)
    __builtin_amdgcn_s_setprio(0);
    if (late) {
      if (t + 1 < nk) { G_STORE((t + 1) & 1) }
      if (t + 2 < nk) { G_LOAD(t + 2) }
    }
    __syncthreads();
  }
#undef G_LOAD
#undef G_STORE
#undef G_COMPUTE
}

struct Xcd { int id, slot, n; };
#define XCD_TILE_LOOP(MTOT, NTOT, mt, nt)                                             \
  for (int j_ = xc.slot, mt, nt; j_ < ((MTOT) / 8) * (NTOT) && (mt = xc.id * ((MTOT) / 8) + j_ % ((MTOT) / 8), nt = j_ / ((MTOT) / 8), true); j_ += xc.n)

template <int MT>
DI void zero_acc(f32x16 (&acc)[MT][2]) {
#pragma unroll
  for (int i = 0; i < MT; i++)
#pragma unroll
    for (int j = 0; j < 2; j++)
#pragma unroll
      for (int r = 0; r < 16; r++) acc[i][j][r] = 0.f;
}

DI void stage_q(f32x16 (&acc)[4][2], float* sC, const int tid, const int mh, const int nh) {
  const int lane = tid & 63, wave = tid >> 6, wm = wave >> 2, wn = wave & 3;
  if (wm == mh && (wn >> 1) == nh) {
#pragma unroll
    for (int i = 0; i < 4; i++)
#pragma unroll
      for (int j = 0; j < 2; j++)
#pragma unroll
        for (int r = 0; r < 16; r++) {
          int row = i * 32 + 8 * (r >> 2) + 4 * (lane >> 5) + (r & 3);
          int col = (wn & 1) * 64 + j * 32 + (lane & 31);
          sC[row * 132 + col] = acc[i][j][r];
        }
  }
  __syncthreads();
}
DI void stage_q_tr(f32x16 (&acc)[4][2], float* sC, const int tid, const int mh, const int nh) {
  const int lane = tid & 63, wave = tid >> 6, wm = wave >> 2, wn = wave & 3;
  if (wm == mh && (wn >> 1) == nh) {
#pragma unroll
    for (int i = 0; i < 4; i++)
#pragma unroll
      for (int j = 0; j < 2; j++)
#pragma unroll
        for (int rq = 0; rq < 4; rq++) {
          int row = i * 32 + 8 * rq + 4 * (lane >> 5);
          int col = (wn & 1) * 64 + j * 32 + (lane & 31);
          float4 v = make_float4(acc[i][j][rq * 4], acc[i][j][rq * 4 + 1], acc[i][j][rq * 4 + 2], acc[i][j][rq * 4 + 3]);
          *(float4*)(sC + col * 132 + row) = v;
        }
  }
  __syncthreads();
}
DI void unstage_q(f32x16 (&acc)[4][2], const float* sC, const int tid, const int mh, const int nh) {
  const int lane = tid & 63, wave = tid >> 6, wm = wave >> 2, wn = wave & 3;
  if (wm == mh && (wn >> 1) == nh) {
#pragma unroll
    for (int i = 0; i < 4; i++)
#pragma unroll
      for (int j = 0; j < 2; j++)
#pragma unroll
        for (int r = 0; r < 16; r++) {
          int row = i * 32 + 8 * (r >> 2) + 4 * (lane >> 5) + (r & 3);
          int col = (wn & 1) * 64 + j * 32 + (lane & 31);
          acc[i][j][r] = sC[row * 132 + col];
        }
  }
  __syncthreads();
}
DI void stage_h1(f32x16 (&acc)[1][2], float* sC, const int tid, const int nh) {
  const int lane = tid & 63, wave = tid >> 6, wm = wave >> 2, wn = wave & 3;
  if ((wn >> 1) == nh) {
#pragma unroll
    for (int j = 0; j < 2; j++)
#pragma unroll
      for (int r = 0; r < 16; r++) {
        int row = wm * 32 + 8 * (r >> 2) + 4 * (lane >> 5) + (r & 3);
        int col = (wn & 1) * 64 + j * 32 + (lane & 31);
        sC[row * 132 + col] = acc[0][j][r];
      }
  }
  __syncthreads();
}

DI void ln16_write(float (&v)[16], const float* g, const float* bt, float* dstf, u16* dstb, int lane) {
  float s = 0.f;
#pragma unroll
  for (int i = 0; i < 16; i++) s += v[i];
  float mu = wave_sum(s) * (1.f / 1024.f);
  float q = 0.f;
#pragma unroll
  for (int i = 0; i < 16; i++) { float d = v[i] - mu; q += d * d; }
  float rstd = rsqrtf(wave_sum(q) * (1.f / 1024.f) + 1e-5f);
#pragma unroll
  for (int c = 0; c < 4; c++) {
    int e = (lane + 64 * c) * 4;
    float4 gg = *(const float4*)(g + e), bb = *(const float4*)(bt + e);
    float4 o;
    o.x = (v[c * 4 + 0] - mu) * rstd * gg.x + bb.x;
    o.y = (v[c * 4 + 1] - mu) * rstd * gg.y + bb.y;
    o.z = (v[c * 4 + 2] - mu) * rstd * gg.z + bb.z;
    o.w = (v[c * 4 + 3] - mu) * rstd * gg.w + bb.w;
    if (dstf) *(float4*)(dstf + e) = o;
    if (dstb) { uint2 pk; pk.x = pack2(o.x, o.y); pk.y = pack2(o.z, o.w); *(uint2*)(dstb + e) = pk; }
  }
}

DI void transpose_tile(const float* __restrict__ src, int ldsrc, u16* __restrict__ dst, int lddst, float* tile  , const int tid, const bool act) {
  __syncthreads();
#pragma unroll
  for (int i = 0; i < 4; i++) {
    int r = (tid >> 4) + 16 * i, c4 = (tid & 15) * 4;
    float4 v = *(const float4*)(src + (long)r * ldsrc + c4);
    tile[r * 65 + c4] = v.x; tile[r * 65 + c4 + 1] = v.y; tile[r * 65 + c4 + 2] = v.z; tile[r * 65 + c4 + 3] = v.w;
  }
  __syncthreads();
#pragma unroll
  for (int i = 0; i < 2; i++) {
    int unit = tid + 256 * i, n = unit >> 3, ch = unit & 7;
    uint4 o;
    o.x = pack2(tile[(ch * 8 + 0) * 65 + n], tile[(ch * 8 + 1) * 65 + n]);
    o.y = pack2(tile[(ch * 8 + 2) * 65 + n], tile[(ch * 8 + 3) * 65 + n]);
    o.z = pack2(tile[(ch * 8 + 4) * 65 + n], tile[(ch * 8 + 5) * 65 + n]);
    o.w = pack2(tile[(ch * 8 + 6) * 65 + n], tile[(ch * 8 + 7) * 65 + n]);
    if (act) *(uint4*)(dst + (long)n * lddst + ch * 8) = o;
  }
}

DI void ph_prep(const P& p, char* smem, int bid, int nb) {
  constexpr int VT = 256;
  const int tid = opaque_vtid(), lane = tid & 63, wave = tid >> 6;
  for (int row = bid * 4 + wave; row < T; row += nb * 4) {
    const float* src = p.x + (long)row * 1024;
    float v[16];
#pragma unroll
    for (int c = 0; c < 4; c++) { float4 t = *(const float4*)(src + (lane + 64 * c) * 4); v[c * 4] = t.x; v[c * 4 + 1] = t.y; v[c * 4 + 2] = t.z; v[c * 4 + 3] = t.w; }
    int b = row >> 13, s = row & 8191;
    int tp = (b << 13) + (s & 63) * 128 + (s >> 6);
    ln16_write(v, p.ln0g, p.ln0b, p.XS + (long)tp * 1024, p.XB + (long)tp * 1024, lane);
  }
  for (int r = bid * 4 + wave; r < 65536; r += nb * 4) {
    const int tb = r >> 15, rr = r & 32767;
    const float* src = (tb ? p.pv : p.pu) + (long)rr * 1024;
    float v[16];
#pragma unroll
    for (int c = 0; c < 4; c++) { float4 t = *(const float4*)(src + (lane + 64 * c) * 4); v[c * 4] = t.x; v[c * 4 + 1] = t.y; v[c * 4 + 2] = t.z; v[c * 4 + 3] = t.w; }
    float am = 0.f;
#pragma unroll
    for (int i = 0; i < 16; i++) am = fmaxf(am, fabsf(v[i]));
    { am = fmaxf(am, shx<32>(am)); am = fmaxf(am, shx<16>(am)); am = fmaxf(am, shx<8>(am)); am = fmaxf(am, shx<4>(am)); am = fmaxf(am, shx<2>(am)); am = fmaxf(am, shx<1>(am)); }
    const float inv = am > 0.f ? 127.f / am : 0.f;
    unsigned char* dst = (tb ? p.V8 : p.U8) + (long)rr * 1024;
#pragma unroll
    for (int c = 0; c < 4; c++) {
      unsigned q0 = (unsigned)((int)rintf(v[c * 4] * inv) + 128), q1 = (unsigned)((int)rintf(v[c * 4 + 1] * inv) + 128);
      unsigned q2 = (unsigned)((int)rintf(v[c * 4 + 2] * inv) + 128), q3 = (unsigned)((int)rintf(v[c * 4 + 3] * inv) + 128);
      *(unsigned*)(dst + (lane + 64 * c) * 4) = q0 | (q1 << 8) | (q2 << 16) | (q3 << 24);
    }
    if (lane == 0) (tb ? p.SV : p.SU)[rr] = am * (1.f / 127.f);
  }
  for (int i = bid * VT + tid; i < 2 * 8 * 2 * 128 * 128 / 8; i += nb * VT) {
    const float* s = p.sk + (long)i * 8;
    float4 a = *(const float4*)s, b = *(const float4*)(s + 4);
    uint4 o; o.x = pack2(a.x, a.y); o.y = pack2(a.z, a.w); o.z = pack2(b.x, b.y); o.w = pack2(b.z, b.w);
    *(uint4*)(p.SK + (long)i * 8) = o;
  }
  {
    float* tile = (float*)smem;
    const int per_layer = 704 + 128 + 128 + 256 + 512;
    for (int it0 = 0; it0 < 2 * per_layer; it0 += nb) {
      int it = it0 + bid; const bool act = it < 2 * per_layer; if (!act) it = 0;
      int l = it / per_layer, r = it % per_layer;
      const float* src; u16* dst; int ldsrc, lddst, kt, nt;
      if (r < 704) { kt = r / 44; nt = r % 44; src = p.w_in + (long)l * 1024 * 3328 + 512; ldsrc = 3328; dst = p.WIN + ((long)l * 3328 + 512) * 1024; lddst = 1024; }
      else if (r < 832) { r -= 704; kt = r / 16; nt = r % 16; src = p.w_bf + (long)l * 512 * 1024; ldsrc = 1024; dst = p.WBF + (long)l * 1024 * 512; lddst = 512; }
      else if (r < 960) { r -= 832; kt = r / 16; nt = r % 16; src = p.w_ba + (long)l * 512 * 1024; ldsrc = 1024; dst = p.WBA + (long)l * 1024 * 512; lddst = 512; }
      else if (r < 1216) { r -= 960; kt = r / 16; nt = r % 16; src = p.w_out + (long)l * 1024 * 1024; ldsrc = 1024; dst = p.WOUT + (long)l * 1024 * 1024; lddst = 1024; }
      else { r -= 1216; kt = r / 32; nt = r % 32; src = p.w_q + (long)l * 1024 * 2048; ldsrc = 2048; dst = p.WQ + (long)l * 2048 * 1024; lddst = 1024; }
      transpose_tile(src + (long)kt * 64 * ldsrc + nt * 64, ldsrc, dst + (long)nt * 64 * lddst + kt * 64, lddst, tile, tid, act);
    }
    __syncthreads();
  }
  {
    float* wt = (float*)smem;
    float* ctab = wt + 16 * 128;
    if (tid < 128) ctab[tid] = cospif((float)tid / 64.f);
    for (int it0 = 0; it0 < 2 * 4 * 64; it0 += nb) {
      int it = it0 + bid; const bool act = it < 2 * 4 * 64; if (!act) it = 0;
      int l = it >> 8, g = (it >> 6) & 3, kt = it & 63;
      __syncthreads();
      for (int e = tid; e < 16 * 32; e += VT) {
        int kr = e >> 5, c4 = (e & 31) * 4;
        *(float4*)(wt + kr * 128 + c4) = *(const float4*)(p.w_in + ((long)l * 1024 + kt * 16 + kr) * 3328 + g * 128 + c4);
      }
      __syncthreads();
      int j = tid & 127, kh = tid >> 7;
      int cp, off; float sgn;
      if (j < 65) { cp = j; off = 0; sgn = 0.08838834764831845f; } else { cp = j - 64; off = 96; sgn = -0.08838834764831845f; }
      float a[8];
#pragma unroll
      for (int q = 0; q < 8; q++) a[q] = 0.f;
      for (int d = 0; d < 128; d++) {
        float bs = ctab[(cp * d + off) & 127];
#pragma unroll
        for (int q = 0; q < 8; q++) a[q] += wt[(kh * 8 + q) * 128 + d] * bs;
      }
      uint4 o; o.x = pack2(a[0] * sgn, a[1] * sgn); o.y = pack2(a[2] * sgn, a[3] * sgn); o.z = pack2(a[4] * sgn, a[5] * sgn); o.w = pack2(a[6] * sgn, a[7] * sgn);
      if (act) *(uint4*)(p.WIN + ((long)l * 3328 + g * 128 + j) * 1024 + kt * 16 + kh * 8) = o;
    }
    __syncthreads();
  }
  for (int i = bid * VT + tid; i < 65536; i += nb * VT) {
    int m = i >> 8, kk = i & 255;
    int mh = m >> 7, po = (m >> 6) & 1, k1 = mh * 64 + (m & 63);
    int pi = kk >> 7, s1 = kk & 127;
    int a = (k1 * s1) & 127;
    float c = cospif((float)a / 64.f), s = sinpif((float)a / 64.f);
    float v = (po == pi) ? c : (po == 0 ? s : -s);
    p.D256[i] = f2bf(v * 0.08838834764831845f);
  }
  for (int i = bid * VT + tid; i < 8192; i += nb * VT) {
    int k2 = i >> 7, kk = i & 127, pi = kk >> 6, s2 = kk & 63;
    int a = (k2 * s2) & 63;
    float v = pi ? sinpif((float)a / 32.f) : cospif((float)a / 32.f);
    p.C64[i] = f2bf(v * 0.125f);
    int k1 = i >> 6, t2 = i & 63;
    float ph = (float)(k1 * t2) / 4096.f;
    p.TW[i] = make_float2(cospif(ph), sinpif(ph));
  }
  for (int i = bid * VT + tid; i < 2048; i += nb * VT) {
    int pos = i >> 4, f = i & 15;
    float inv = 1.0f / powf(10000.f, (float)(2 * f) / 32.f);
    float ang = (float)pos * inv;
    p.ROPE[i] = make_float2(cosf(ang), sinf(ang));
  }
}

DI void inproj_epi_fourier(const P& p, const float* sC, int mt, int g, const int tid) {
  const int b = mt >> 6, s2 = mt & 63;
#pragma unroll 1
  for (int unit = tid; unit < 2048; unit += NTHR) {
    int j = unit >> 4, ch = unit & 15;
    float4 a = *(const float4*)(sC + j * 132 + ch * 8), c = *(const float4*)(sC + j * 132 + ch * 8 + 4);
    uint4 o; o.x = pack2(a.x, a.y); o.y = pack2(a.z, a.w); o.z = pack2(c.x, c.y); o.w = pack2(c.z, c.w);
    int cp = (j < 65) ? j : j - 64, part = (j < 65) ? 0 : 1;
    long rowi = ((long)(b * 4 + g) * 65 + cp) * 64 + s2;
    *(uint4*)(p.ZT + rowi * 256 + part * 128 + ch * 8) = o;
  }
  if (tid < 32) {
    int cp = (tid < 16) ? 0 : 64, ch = tid & 15;
    long rowi = ((long)(b * 4 + g) * 65 + cp) * 64 + s2;
    unsigned z_; asm volatile("v_mov_b32 %0, 0" : "=v"(z_));
    *(uint4*)(p.ZT + rowi * 256 + 128 + ch * 8) = make_uint4(z_, z_, z_, z_);
  }
}
DI void inproj_epi_qk(const P& p, int l, const float* sC, int mt, int nt, const int tid) {
  const int b = mt >> 6, s2 = mt & 63;
  if (tid < 256) {
    const int row = tid & 127, hd = tid >> 7;
    const float* sr = sC + row * 132 + hd * 64;
    float ss = 0.f;
#pragma unroll
    for (int i = 0; i < 16; i++) { float4 t = *(const float4*)(sr + i * 4); ss += t.x * t.x + t.y * t.y + t.z * t.z + t.w * t.w; }
    const bool isq = nt < 8;
    const float* gn = (isq ? p.qng : p.kng) + l * 64;
    const float rinv = rsqrtf(ss * (1.f / 64.f) + 1e-6f) * (isq ? (0.125f * 1.4426950408889634f) : 1.f);
    const int s1 = row;
    const int u = s2 * 128 + s1;
    u16* dst;
    if (isq) { int h = (nt - 4) * 2 + hd; dst = p.Q + ((long)(b * 8 + h) * 8192 + u) * 64; }
    else { dst = p.K + ((long)(b * 2 + hd) * 8192 + u) * 64; }
#pragma unroll 1
    for (int ax = 0; ax < 2; ax++) {
      const int pos = ax ? s2 : s1;
#pragma unroll 1
      for (int fq = 0; fq < 2; fq++) {
        float x0[8], x1[8], o0[8], o1[8];
#pragma unroll
        for (int e = 0; e < 8; e++) {
          int d0 = ax * 32 + fq * 8 + e, d1 = d0 + 16;
          x0[e] = sr[d0] * rinv * gn[d0];
          x1[e] = sr[d1] * rinv * gn[d1];
          float2 cs = p.ROPE[pos * 16 + fq * 8 + e];
          o0[e] = x0[e] * cs.x - x1[e] * cs.y;
          o1[e] = x1[e] * cs.x + x0[e] * cs.y;
        }
        uint4 pk;
        pk.x = pack2(o0[0], o0[1]); pk.y = pack2(o0[2], o0[3]); pk.z = pack2(o0[4], o0[5]); pk.w = pack2(o0[6], o0[7]);
        *(uint4*)(dst + ax * 32 + fq * 8) = pk;
        pk.x = pack2(o1[0], o1[1]); pk.y = pack2(o1[2], o1[3]); pk.z = pack2(o1[4], o1[5]); pk.w = pack2(o1[6], o1[7]);
        *(uint4*)(dst + ax * 32 + 16 + fq * 8) = pk;
      }
    }
  }
}
DI void inproj_epi_v(const P& p, const float* sC, int mt, const int tid) {
  const int b = mt >> 6, s2 = mt & 63;
#pragma unroll 1
  for (int unit = tid; unit < 2048; unit += NTHR) {
    int j = unit >> 4, ch = unit & 15;
    float4 a = *(const float4*)(sC + j * 132 + ch * 8), c = *(const float4*)(sC + j * 132 + ch * 8 + 4);
    uint4 o; o.x = pack2(a.x, a.y); o.y = pack2(a.z, a.w); o.z = pack2(c.x, c.y); o.w = pack2(c.z, c.w);
    *(uint4*)(p.VT + ((long)(b * 2) * 64 + j) * 8192 + s2 * 128 + ch * 8) = o;
  }
}
DI void inproj_epi_gates(const P& p, int l, const float* sC, int mt, int nt, const int tid) {
  const int c0 = (nt - 10) * 128;
  const float* bg = p.b_gate + l * 2048 + c0;
#pragma unroll 1
  for (int unit = tid; unit < 2048; unit += NTHR) {
    int row = unit >> 4, ch = unit & 15;
    float4 a = *(const float4*)(sC + row * 132 + ch * 8), c = *(const float4*)(sC + row * 132 + ch * 8 + 4);
    float4 ba = *(const float4*)(bg + ch * 8), bc = *(const float4*)(bg + ch * 8 + 4);
    float r0 = 1.f / (1.f + __expf(-(a.x + ba.x))), r1 = 1.f / (1.f + __expf(-(a.y + ba.y)));
    float r2 = 1.f / (1.f + __expf(-(a.z + ba.z))), r3 = 1.f / (1.f + __expf(-(a.w + ba.w)));
    float r4 = 1.f / (1.f + __expf(-(c.x + bc.x))), r5 = 1.f / (1.f + __expf(-(c.y + bc.y)));
    float r6 = 1.f / (1.f + __expf(-(c.z + bc.z))), r7 = 1.f / (1.f + __expf(-(c.w + bc.w)));
    uint4 o; o.x = pack2(r0, r1); o.y = pack2(r2, r3); o.z = pack2(r4, r5); o.w = pack2(r6, r7);
    *(uint4*)(p.GATES + ((long)mt * 128 + row) * 2048 + c0 + ch * 8) = o;
  }
}

DI void ph_inproj(const P& p, int l, char* smem, int bid, int nb, const Xcd xc) {
  const int tid = opaque_tid();
  float* sC = (float*)smem;
  const u16* W = p.WIN + (long)l * 3328 * 1024;
  XCD_TILE_LOOP(64, 12, mt2, nt2) {
    f32x16 acc[4][2];
    zero_acc<4>(acc);
    gemm_main<4>(p.XB + (long)mt2 * 256 * 1024, 1024, W + (long)nt2 * 256 * 1024, 1024, 1024, acc, smem, tid, j_);
#pragma unroll 1
    for (int q = 0; q < 4; q++) {
      const int mh = q >> 1, nh = q & 1, mt = mt2 * 2 + mh, nt = nt2 * 2 + nh;
      if (nt < 4) { stage_q_tr(acc, sC, tid, mh, nh); inproj_epi_fourier(p, sC, mt, nt, opaque_tid()); }
      else if (nt < 9) { stage_q(acc, sC, tid, mh, nh); inproj_epi_qk(p, l, sC, mt, nt, opaque_tid()); }
      else if (nt == 9) { stage_q_tr(acc, sC, tid, mh, nh); inproj_epi_v(p, sC, mt, opaque_tid()); }
      else { stage_q(acc, sC, tid, mh, nh); inproj_epi_gates(p, l, sC, mt, nt, opaque_tid()); }
      __syncthreads();
    }
  }
  for (int j_ = xc.slot; j_ < 32; j_ += xc.n) {
    const int mt4 = xc.id * 32 + j_;
    f32x16 acc1[1][2];
    zero_acc<1>(acc1);
    gemm_main<1>(p.XB + (long)mt4 * 64 * 1024, 1024, W + (long)12 * 256 * 1024, 1024, 1024, acc1, smem, tid, j_);
#pragma unroll 1
    for (int nh = 0; nh < 2; nh++) {
      stage_h1(acc1, sC, tid, nh);
      const int c0 = (24 + nh - 10) * 128;
      const float* bg = p.b_gate + l * 2048 + c0;
#pragma unroll 1
      for (int unit = opaque_tid(); unit < 1024; unit += NTHR) {
        int row = unit >> 4, ch = unit & 15;
        float4 a = *(const float4*)(sC + row * 132 + ch * 8), c = *(const float4*)(sC + row * 132 + ch * 8 + 4);
        float4 ba = *(const float4*)(bg + ch * 8), bc = *(const float4*)(bg + ch * 8 + 4);
        float r0 = 1.f / (1.f + __expf(-(a.x + ba.x))), r1 = 1.f / (1.f + __expf(-(a.y + ba.y)));
        float r2 = 1.f / (1.f + __expf(-(a.z + ba.z))), r3 = 1.f / (1.f + __expf(-(a.w + ba.w)));
        float r4 = 1.f / (1.f + __expf(-(c.x + bc.x))), r5 = 1.f / (1.f + __expf(-(c.y + bc.y)));
        float r6 = 1.f / (1.f + __expf(-(c.z + bc.z))), r7 = 1.f / (1.f + __expf(-(c.w + bc.w)));
        uint4 o; o.x = pack2(r0, r1); o.y = pack2(r2, r3); o.z = pack2(r4, r5); o.w = pack2(r6, r7);
        *(uint4*)(p.GATES + ((long)mt4 * 64 + row) * 2048 + c0 + ch * 8) = o;
      }
      __syncthreads();
    }
  }
}

DI void ph_fftA(const P& p, char* smem, int bid, int nb) {
  const int tid = opaque_tid();
  float* sC = (float*)smem;
  for (int t2 = bid; t2 < 130; t2 += nb) {
    f32x16 acc[4][2];
    zero_acc<4>(acc);
    gemm_main<4>(p.D256, 256, p.ZT + (long)t2 * 256 * 256, 256, 256, acc, smem, tid, t2);
#pragma unroll 1
    for (int q = 0; q < 4; q++) {
      const int mh = q >> 1, nh = q & 1, ntile = t2 * 2 + nh;
      stage_q(acc, sC, tid, mh, nh);
      if (tid < 256) {
        const int k1l = tid & 63, ch = (tid >> 6) & 1, po = tid >> 7;
        const int k1 = mh * 64 + k1l;
        const int qd = ntile * 2 + ch, bg = qd / 65, cp = qd % 65;
        u16* dst = p.GP + (((long)bg * 128 + k1) * 65 + cp) * 128 + po * 64;
        const float2* tw = p.TW + k1 * 64;
#pragma unroll 2
        for (int i = 0; i < 8; i++) {
          float o[8];
#pragma unroll
          for (int e = 0; e < 8; e++) {
            int s2 = i * 8 + e;
            float gr = sC[k1l * 132 + ch * 64 + s2], gi = sC[(64 + k1l) * 132 + ch * 64 + s2];
            float2 cs = tw[s2];
            o[e] = po ? (gi * cs.x - gr * cs.y) : (gr * cs.x + gi * cs.y);
          }
          uint4 pk; pk.x = pack2(o[0], o[1]); pk.y = pack2(o[2], o[3]); pk.z = pack2(o[4], o[5]); pk.w = pack2(o[6], o[7]);
          *(uint4*)(dst + i * 8) = pk;
        }
      }
      __syncthreads();
    }
  }
}

DI void ph_fftC(const P& p, char* smem, int bid, int nb) {
  const int tid = opaque_tid();
  float* sC = (float*)smem;
  for (int t2 = bid; t2 < 260; t2 += nb) {
    f32x16 acc[1][2];
    zero_acc<1>(acc);
    gemm_main<1>(p.C64, 128, p.GP + (long)t2 * 256 * 128, 128, 128, acc, smem, tid, 0);
#pragma unroll 1
    for (int nh = 0; nh < 2; nh++) {
      stage_h1(acc, sC, tid, nh);
      const int tile = t2 * 2 + nh;
      const int nl = tid & 127, kh = tid >> 7;
      const int idx = tile * 128 + nl;
      const int cp = idx % 65, k1 = (idx / 65) & 127, bg = idx / (65 * 128);
      const int b = bg >> 2, g = bg & 3;
      const bool mir = (cp >= 1 && cp <= 63);
      for (int i = 0; i < 16; i++) {
        int k2 = kh * 16 + i;
        u16 v = f2bf(sC[k2 * 132 + nl]);
        int k = k1 + 128 * k2;
        long tp = (long)b * 8192 + (k & 63) * 128 + (k >> 6);
        p.Y[tp * 512 + g * 128 + cp] = v;
        if (mir) {
          int km = (8192 - k) & 8191;
          long tm = (long)b * 8192 + (km & 63) * 128 + (km >> 6);
          p.Y[tm * 512 + g * 128 + 128 - cp] = v;
        }
      }
      __syncthreads();
    }
  }
}

DI void attn_item(const P& p, int l, int item, char* smem, const int tid, const int rot, const bool late) {
  const int lane = tid & 63, wave = tid >> 6;
  const int hg = item & 3, qb = (item >> 2) & 31, kvh = (item >> 7) & 1, b = item >> 8;
  const int h = kvh * 4 + hg;
  const int ql = lane & 31, hf = lane >> 5;
  const u16* Qp = p.Q + ((long)(b * 8 + h) * 8192 + qb * 256 + wave * 64) * 64;
  const u16* Kp = p.K + (long)(b * 2 + kvh) * 8192 * 64;
  const u16* Vp = p.VT + (long)(b * 2 + kvh) * 64 * 8192;
  u16* sK = (u16*)smem;
  u16* sV = sK + 3 * 64 * 72;
  f32x16 o[2][2];
#pragma unroll
  for (int dt = 0; dt < 2; dt++)
#pragma unroll
    for (int qt = 0; qt < 2; qt++)
#pragma unroll
      for (int r = 0; r < 16; r++) o[dt][qt][r] = 0.f;
  f32x2 ls[2] = {f32x2{0.f, 0.f}, f32x2{0.f, 0.f}};
  const int lr = tid >> 3, lc = (tid & 7) * 8;
  u32x4 rk[2], rv[2];
  __syncthreads();
#pragma unroll
  for (int c = 0; c < 2; c++) {
    rk[c] = *(const u32x4*)((const char*)Kp + ((long)(rot & 127) * 8192 + c * 4096) + (unsigned)((lr * 64 + lc) * 2));
    rv[c] = *(const u32x4*)((const char*)Vp + ((long)(rot & 127) * 128 + (long)c * 32 * 8192 * 2) + (unsigned)((lr * 8192 + lc) * 2));
  }
#pragma unroll
  for (int c = 0; c < 2; c++) {
    *(u32x4*)(sK + (lr + 32 * c) * 72 + lc) = rk[c];
    *(u32x4*)(sV + (lr + 32 * c) * 72 + lc) = rv[c];
  }
  __syncthreads();
  __builtin_amdgcn_sched_barrier(0);
  bf16x8 qf[2][4];
  float bound[2];
  float kmax = fabsf(p.kng[l * 64 + lane]);
  { kmax = fmaxf(kmax, shx<32>(kmax)); kmax = fmaxf(kmax, shx<16>(kmax)); kmax = fmaxf(kmax, shx<8>(kmax)); kmax = fmaxf(kmax, shx<4>(kmax)); kmax = fmaxf(kmax, shx<2>(kmax)); kmax = fmaxf(kmax, shx<1>(kmax)); }
  kmax *= 8.f * 1.02f;
#pragma unroll
  for (int qt = 0; qt < 2; qt++) {
    float ssq = 0.f;
#pragma unroll
    for (int kd = 0; kd < 4; kd++) {
      qf[qt][kd] = *(const bf16x8*)((const char*)Qp + (long)((qt * 32 * 64 + kd * 16) * 2) + (unsigned)((ql * 64 + hf * 8) * 2));
#pragma unroll
      for (int j = 0; j < 8; j++) { float v = bf2f((u16)qf[qt][kd][j]); ssq += v * v; }
    }
    ssq += shx<32>(ssq);
    bound[qt] = sqrtf(ssq) * kmax;
    __builtin_amdgcn_sched_barrier(0);
  }
  const unsigned offK = (unsigned)((lr * 64 + lc) * 2), offV = (unsigned)((lr * 8192 + lc) * 2);
  const char* Kb = (const char*)Kp;
  const char* Vb = (const char*)Vp;
#define ATT_LOAD(ktile)                                                                                   \
  { const long tk_ = (long)(((ktile) + rot) & 127);                                                       \
    rk[0] = *(const u32x4*)(Kb + tk_ * 8192 + offK); rk[1] = *(const u32x4*)(Kb + (tk_ * 8192 + 4096) + offK);          \
    rv[0] = *(const u32x4*)(Vb + tk_ * 128 + offV);  rv[1] = *(const u32x4*)(Vb + (tk_ * 128 + 32 * 8192 * 2) + offV); }
#define ATT_STORE(buf3)                                                                                   \
  { u16* nK = sK + (buf3) * 64 * 72; u16* nV = sV + (buf3) * 64 * 72;                                     \
    _Pragma("unroll") for (int c = 0; c < 2; c++) {                                                       \
      *(u32x4*)(nK + (lr + 32 * c) * 72 + lc) = rk[c];                                                    \
      *(u32x4*)(nV + (lr + 32 * c) * 72 + lc) = rv[c];                                                    \
    } }
#define ATT_KS(ks)                                                                                        \
    {                                                                                                     \
      f32x16 st[2];                                                                                       \
      _Pragma("unroll") for (int qt = 0; qt < 2; qt++)                                                    \
        _Pragma("unroll") for (int r = 0; r < 16; r++) st[qt][r] = -bound[qt];                            \
      _Pragma("unroll") for (int kd = 0; kd < 4; kd++) {                                                  \
        bf16x8 kf = *(const bf16x8*)(cK + ((ks) * 32 + ql) * 72 + kd * 16 + hf * 8);                      \
        _Pragma("unroll") for (int qt = 0; qt < 2; qt++) st[qt] = MFMA(kf, qf[qt][kd], st[qt]);           \
      }                                                                                                   \
      _Pragma("unroll") for (int qt = 0; qt < 2; qt++)                                                    \
        _Pragma("unroll") for (int r = 0; r < 16; r += 2) {                                               \
          float e0 = __builtin_amdgcn_exp2f(st[qt][r]), e1 = __builtin_amdgcn_exp2f(st[qt][r + 1]);      \
          st[qt][r] = e0; st[qt][r + 1] = e1;                                                             \
          ls[qt] += f32x2{e0, e1};                                                                        \
        }                                                                                                 \
      _Pragma("unroll") for (int s = 0; s < 2; s++) {                                                     \
        bf16x8 pf[2];                                                                                     \
        _Pragma("unroll") for (int qt = 0; qt < 2; qt++)                                                  \
          _Pragma("unroll") for (int j = 0; j < 8; j++) pf[qt][j] = (short)f2bf(st[qt][8 * s + j]);       \
        _Pragma("unroll") for (int dt = 0; dt < 2; dt++) {                                                \
          const u16* vp = cV + (dt * 32 + ql) * 72 + (ks) * 32 + 16 * s + 4 * hf;                         \
          s16x4 lo = *(const s16x4*)vp, hi = *(const s16x4*)(vp + 8);                                     \
          bf16x8 vf = __builtin_shufflevector(lo, hi, 0, 1, 2, 3, 4, 5, 6, 7);                            \
          _Pragma("unroll") for (int qt = 0; qt < 2; qt++) o[dt][qt] = MFMA(vf, pf[qt], o[dt][qt]);       \
        }                                                                                                 \
      }                                                                                                   \
      __builtin_amdgcn_sched_barrier(0);                                                                  \
    }
  if (late) { ATT_LOAD(1) }
  int cur3 = 0;
  for (int kt = 0; kt < 128; kt++) {
    const int nxt3 = (cur3 == 2) ? 0 : cur3 + 1;
    const u16* cK = sK + cur3 * 64 * 72;
    const u16* cV = sV + cur3 * 64 * 72;
    if (!late) { if (kt + 1 < 128) { ATT_LOAD(kt + 1) } }
    ATT_KS(0)
    if (late) {
      if (kt + 1 < 128) { ATT_STORE(nxt3) }
      __syncthreads();
      if (kt + 2 < 128) { ATT_LOAD(kt + 2) }
    }
    ATT_KS(1)
    if (!late) {
      if (kt + 1 < 128) { ATT_STORE(nxt3) }
      __syncthreads();
    }
    cur3 = nxt3;
  }
  __syncthreads();
#undef ATT_LOAD
#undef ATT_STORE
#undef ATT_KS
  const int te_ = opaque_vtid();
  const int lane_e = te_ & 63, wave_e = te_ >> 6, ql_e = lane_e & 31, hf_e = lane_e >> 5;
  u16* sO = (u16*)smem + wave_e * 64 * 72;
#pragma unroll
  for (int qt = 0; qt < 2; qt++) {
    float lt = ls[qt].x + ls[qt].y;
    lt += shx<32>(lt);
    const float inv = 1.f / lt;
#pragma unroll
    for (int dt = 0; dt < 2; dt++)
#pragma unroll
      for (int rq = 0; rq < 4; rq++) {
        int d = dt * 32 + 8 * rq + 4 * hf_e;
        uint2 pk; pk.x = pack2(o[dt][qt][rq * 4] * inv, o[dt][qt][rq * 4 + 1] * inv); pk.y = pack2(o[dt][qt][rq * 4 + 2] * inv, o[dt][qt][rq * 4 + 3] * inv);
        *(uint2*)(sO + (qt * 32 + ql_e) * 72 + d) = pk;
      }
  }
  __syncthreads();
  u16* dst = p.AO + ((long)b * 8192 + qb * 256 + wave_e * 64) * 512 + h * 64;
#pragma unroll 2
  for (int i = 0; i < 8; i++) {
    int unit = lane_e + 64 * i, q = unit >> 3, ch = unit & 7;
    *(uint4*)(dst + (long)q * 512 + ch * 8) = *(const uint4*)(sO + q * 72 + ch * 8);
  }
  __syncthreads();
}

DI void ph_attn(const P& p, int l, char* smem, const Xcd xc, const int vb) {
  const int tid = opaque_vtid();
  for (int base = xc.slot * 2; base < 64; base += xc.n * 2) {
    const int sl = base + vb;
    attn_item(p, l, ((xc.id >> 1) << 7) | ((xc.id & 1) << 6) | sl, smem, tid, sl * 2, vb != 0);
  }
}

DI void ph_branch(const P& p, int l, char* smem, int bid, int nb, const Xcd xc) {
  const int tid = opaque_tid();
  float* sC = (float*)smem;
  XCD_TILE_LOOP(64, 4, mt2, nt2) {
    f32x16 a1[4][2];
    zero_acc<4>(a1);
    gemm_main<4>(p.Y + (long)mt2 * 256 * 512, 512, p.WBF + ((long)l * 1024 + nt2 * 256) * 512, 512, 512, a1, smem, tid, j_);
#pragma unroll 1
    for (int q = 0; q < 4; q++) {
      const int mh = q >> 1, nh = q & 1, mt = mt2 * 2 + mh, nt = nt2 * 2 + nh;
      stage_q(a1, sC, tid, mh, nh);
#pragma unroll 1
      for (int unit = opaque_tid(); unit < 2048; unit += NTHR) {
        int row = unit >> 4, ch = unit & 15;
        const u16* gp = p.GATES + ((long)mt * 128 + row) * 2048 + nt * 128 + ch * 8;
        uint4 gf = *(const uint4*)gp, ga = *(const uint4*)(gp + 1024);
        float* sp = sC + row * 132 + ch * 8;
        float4 a = *(const float4*)sp, c = *(const float4*)(sp + 4);
        a.x *= bflo(gf.x) / fmaxf(bflo(ga.x), 1e-20f); a.y *= bfhi(gf.x) / fmaxf(bfhi(ga.x), 1e-20f);
        a.z *= bflo(gf.y) / fmaxf(bflo(ga.y), 1e-20f); a.w *= bfhi(gf.y) / fmaxf(bfhi(ga.y), 1e-20f);
        c.x *= bflo(gf.z) / fmaxf(bflo(ga.z), 1e-20f); c.y *= bfhi(gf.z) / fmaxf(bfhi(ga.z), 1e-20f);
        c.z *= bflo(gf.w) / fmaxf(bflo(ga.w), 1e-20f); c.w *= bfhi(gf.w) / fmaxf(bfhi(ga.w), 1e-20f);
        *(float4*)sp = a; *(float4*)(sp + 4) = c;
      }
      __syncthreads();
      unstage_q(a1, sC, tid, mh, nh);
    }
    gemm_main<4>(p.AO + (long)mt2 * 256 * 512, 512, p.WBA + ((long)l * 1024 + nt2 * 256) * 512, 512, 512, a1, smem, tid, j_);
#pragma unroll 1
    for (int q = 0; q < 4; q++) {
      const int mh = q >> 1, nh = q & 1, mt = mt2 * 2 + mh, nt = nt2 * 2 + nh;
      stage_q(a1, sC, tid, mh, nh);
#pragma unroll 1
      for (int unit = opaque_tid(); unit < 2048; unit += NTHR) {
        int row = unit >> 4, ch = unit & 15;
        uint4 ga = *(const uint4*)(p.GATES + ((long)mt * 128 + row) * 2048 + 1024 + nt * 128 + ch * 8);
        float4 a = *(const float4*)(sC + row * 132 + ch * 8), c = *(const float4*)(sC + row * 132 + ch * 8 + 4);
        uint4 o;
        o.x = pack2(a.x * fmaxf(bflo(ga.x), 1e-20f), a.y * fmaxf(bfhi(ga.x), 1e-20f));
        o.y = pack2(a.z * fmaxf(bflo(ga.y), 1e-20f), a.w * fmaxf(bfhi(ga.y), 1e-20f));
        o.z = pack2(c.x * fmaxf(bflo(ga.z), 1e-20f), c.y * fmaxf(bfhi(ga.z), 1e-20f));
        o.w = pack2(c.z * fmaxf(bflo(ga.w), 1e-20f), c.w * fmaxf(bfhi(ga.w), 1e-20f));
        *(uint4*)(p.MIXED + ((long)mt * 128 + row) * 1024 + nt * 128 + ch * 8) = o;
      }
      __syncthreads();
    }
  }
}

DI void ph_outproj(const P& p, int l, char* smem, int bid, int nb, const Xcd xc) {
  const int tid = opaque_tid();
  float* sC = (float*)smem;
  XCD_TILE_LOOP(64, 4, mt2, nt2) {
    f32x16 acc[4][2];
    zero_acc<4>(acc);
    gemm_main<4>(p.MIXED + (long)mt2 * 256 * 1024, 1024, p.WOUT + ((long)l * 1024 + nt2 * 256) * 1024, 1024, 1024, acc, smem, tid, j_);
#pragma unroll 1
    for (int q = 0; q < 4; q++) {
      const int mh = q >> 1, nh = q & 1, mt = mt2 * 2 + mh, nt = nt2 * 2 + nh;
      stage_q(acc, sC, tid, mh, nh);
#pragma unroll 1
      for (int unit = opaque_tid(); unit < 2048; unit += NTHR) {
        int row = unit >> 4, ch = unit & 15;
        long gi = ((long)mt * 128 + row) * 1024 + nt * 128 + ch * 8;
        float4 a = *(const float4*)(sC + row * 132 + ch * 8), c = *(const float4*)(sC + row * 132 + ch * 8 + 4);
        float4 xa = *(const float4*)(p.XS + gi), xc4 = *(const float4*)(p.XS + gi + 4);
        a.x += ALPHA * xa.x; a.y += ALPHA * xa.y; a.z += ALPHA * xa.z; a.w += ALPHA * xa.w;
        c.x += ALPHA * xc4.x; c.y += ALPHA * xc4.y; c.z += ALPHA * xc4.z; c.w += ALPHA * xc4.w;
        *(float4*)(p.out + gi) = a; *(float4*)(p.out + gi + 4) = c;
      }
      __syncthreads();
    }
  }
}

DI void ph_ln1(const P& p, int l, int bid, int nb) {
  const int tid = opaque_vtid(), lane = tid & 63, wave = tid >> 6;
  for (int row = bid * 4 + wave; row < T; row += nb * 4) {
    const float* src = p.out + (long)row * 1024;
    float v[16];
#pragma unroll
    for (int c = 0; c < 4; c++) { float4 t = *(const float4*)(src + (lane + 64 * c) * 4); v[c * 4] = t.x; v[c * 4 + 1] = t.y; v[c * 4 + 2] = t.z; v[c * 4 + 3] = t.w; }
    ln16_write(v, p.ln1g + l * 1024, p.ln1b + l * 1024, p.XS + (long)row * 1024, p.XB + (long)row * 1024, lane);
  }
}

DI void ph_peerq(const P& p, int l, char* smem, int bid, int nb, const Xcd xc) {
  const int tid = opaque_tid();
  float* sC = (float*)smem;
  XCD_TILE_LOOP(64, 8, mt2, nt2) {
    f32x16 acc[4][2];
    zero_acc<4>(acc);
    gemm_main<4>(p.XB + (long)mt2 * 256 * 1024, 1024, p.WQ + ((long)l * 2048 + nt2 * 256) * 1024, 1024, 1024, acc, smem, tid, j_);
#pragma unroll 1
    for (int q = 0; q < 4; q++) {
      const int mh = q >> 1, nh = q & 1, mt = mt2 * 2 + mh, nt = nt2 * 2 + nh;
      stage_q(acc, sC, tid, mh, nh);
#pragma unroll 1
      for (int unit = opaque_tid(); unit < 2048; unit += NTHR) {
        int row = unit >> 4, ch = unit & 15;
        float4 a = *(const float4*)(sC + row * 132 + ch * 8), c = *(const float4*)(sC + row * 132 + ch * 8 + 4);
        uint4 o; o.x = pack2(a.x, a.y); o.y = pack2(a.z, a.w); o.z = pack2(c.x, c.y); o.w = pack2(c.z, c.w);
        *(uint4*)(p.QP + ((long)mt * 128 + row) * 2048 + nt * 128 + ch * 8) = o;
      }
      __syncthreads();
    }
  }
}

DI int okey(float v) { int b = __float_as_int(v); return b ^ ((b >> 31) & 0x7fffffff); }
DI float okey_val(int k) { return __int_as_float(k ^ ((k >> 31) & 0x7fffffff)); }
DI int med3i(int a, int b, int c) { int r; asm("v_med3_i32 %0, %1, %2, %3" : "=v"(r) : "v"(a), "v"(b), "v"(c)); return r; }
DI void ins16(int (&L)[16], int x) {
#pragma unroll
  for (int i = 15; i > 0; i--) L[i] = med3i(L[i - 1], L[i], x);
  L[0] = max(L[0], x);
}

DI void peer_finish_token(const P& p, int l, bool last, const long tok, f32x2 (&acc2)[8], float csum, const int lane) {
      float acc[16];
#pragma unroll
      for (int i = 0; i < 8; i++) { acc[2 * i] = acc2[i].x; acc[2 * i + 1] = acc2[i].y; }
      csum *= 128.f;
      const float* xs = p.XS + tok * 1024 + lane * 16;
      float y[16];
#pragma unroll
      for (int c = 0; c < 4; c++) {
        float4 a = *(const float4*)(xs + c * 4);
        y[c * 4 + 0] = ALPHA * a.x + acc[c * 4 + 0] - csum; y[c * 4 + 1] = ALPHA * a.y + acc[c * 4 + 1] - csum;
        y[c * 4 + 2] = ALPHA * a.z + acc[c * 4 + 2] - csum; y[c * 4 + 3] = ALPHA * a.w + acc[c * 4 + 3] - csum;
      }
      float s = 0.f;
#pragma unroll
      for (int i = 0; i < 16; i++) s += y[i];
      float mu = wave_sum(s) * (1.f / 1024.f);
      float q = 0.f;
#pragma unroll
      for (int i = 0; i < 16; i++) { float dd = y[i] - mu; q += dd * dd; }
      float rstd = rsqrtf(wave_sum(q) * (1.f / 1024.f) + 1e-5f);
      const float* g = p.ln2g + l * 1024;
      const float* bt = p.ln2b + l * 1024;
      float* dstf;
      if (last) {
        int b = (int)(tok >> 13), u = (int)(tok & 8191);
        int sact = (u & 127) * 64 + (u >> 7);
        dstf = p.out + ((long)b * 8192 + sact) * 1024;
      } else dstf = p.XS + tok * 1024;
      {
        const int e0 = lane * 16;
        float o[16];
#pragma unroll
        for (int c = 0; c < 4; c++) {
          float4 g0 = *(const float4*)(g + e0 + c * 4), b0 = *(const float4*)(bt + e0 + c * 4);
          o[c * 4 + 0] = (y[c * 4 + 0] - mu) * rstd * g0.x + b0.x; o[c * 4 + 1] = (y[c * 4 + 1] - mu) * rstd * g0.y + b0.y;
          o[c * 4 + 2] = (y[c * 4 + 2] - mu) * rstd * g0.z + b0.z; o[c * 4 + 3] = (y[c * 4 + 3] - mu) * rstd * g0.w + b0.w;
          *(float4*)(dstf + e0 + c * 4) = make_float4(o[c * 4], o[c * 4 + 1], o[c * 4 + 2], o[c * 4 + 3]);
        }
        if (!last) {
          uint4 pk; pk.x = pack2(o[0], o[1]); pk.y = pack2(o[2], o[3]); pk.z = pack2(o[4], o[5]); pk.w = pack2(o[6], o[7]);
          *(uint4*)(p.XB + tok * 1024 + e0) = pk;
          pk.x = pack2(o[8], o[9]); pk.y = pack2(o[10], o[11]); pk.z = pack2(o[12], o[13]); pk.w = pack2(o[14], o[15]);
          *(uint4*)(p.XB + tok * 1024 + e0 + 8) = pk;
        }
      }
}

DI void ph_peer(const P& p, int l, char* smem, int bid, int nb, bool last) {
  const int tid = opaque_vtid(), lane = tid & 63, wave = tid >> 6;
  const int tl = lane & 31, hf = lane >> 5;
  int* sel_e = (int*)smem;
  float* sel_w = (float*)(smem + 16384);
  unsigned char* sidx = (unsigned char*)(smem + 32768);
  float* scoef = (float*)(smem + 32768 + 4096);
  const u16* SKl = p.SK + (long)l * 8 * 2 * 128 * 128;
  const unsigned char* Ul = p.U8 + (long)l * 16384 * 1024;
  const unsigned char* Vl = p.V8 + (long)l * 16384 * 1024;
  const float* SUl = p.SU + l * 16384;
  const float* SVl = p.SV + l * 16384;
  for (int tk = bid; tk < T / 32; tk += nb) {
    const int t0 = tk * 32;
    const int tidr_ = opaque_vtid();
    const int lane = tidr_ & 63, wave = tidr_ >> 6, tl = lane & 31, hf = lane >> 5;
    __syncthreads();
    for (int hi = 0; hi < 2; hi++) {
      const int hh = wave + 4 * hi;
      int L1[16], L2[16];
#pragma unroll
      for (int half = 0; half < 2; half++) {
        f32x16 acc[4];
#pragma unroll
        for (int mt = 0; mt < 4; mt++)
#pragma unroll
          for (int r = 0; r < 16; r++) acc[mt][r] = 0.f;
        const u16* qrow = p.QP + (long)(t0 + tl) * 2048 + hh * 256 + half * 128 + hf * 8;
        const u16* krow = SKl + ((long)(hh * 2 + half) * 128 + tl) * 128 + hf * 8;
#pragma unroll
        for (int kd = 0; kd < 8; kd++) {
          bf16x8 bq = *(const bf16x8*)(qrow + kd * 16);
#pragma unroll
          for (int mt = 0; mt < 4; mt++) {
            bf16x8 ak = *(const bf16x8*)(krow + (long)mt * 32 * 128 + kd * 16);
            acc[mt] = MFMA(ak, bq, acc[mt]);
          }
          if (kd == 3) __builtin_amdgcn_sched_barrier(0);
        }
        int L[16];
#pragma unroll
        for (int i = 0; i < 16; i++) L[i] = (int)0x80000000;
#pragma unroll
        for (int mt = 0; mt < 4; mt++)
#pragma unroll
          for (int r = 0; r < 16; r++) {
            int key = mt * 32 + 8 * (r >> 2) + 4 * hf + (r & 3);
            int k = (okey(acc[mt][r]) & ~0x7f) | (127 - key);
            ins16(L, k);
          }
        int S[16];
#pragma unroll
        for (int i = 0; i < 16; i++) S[i] = L[i];
#pragma unroll
        for (int i = 0; i < 16; i++) { int pv = shxi<32>(S[i]); ins16(L, pv); }
        if (half == 0) {
#pragma unroll
          for (int i = 0; i < 16; i++) L1[i] = L[i];
        } else {
#pragma unroll
          for (int i = 0; i < 16; i++) L2[i] = L[i];
        }
      }
      float v1[16], v2[16];
#pragma unroll
      for (int i = 0; i < 16; i++) { v1[i] = okey_val(L1[i] & ~0x7f); v2[i] = okey_val(L2[i] & ~0x7f); }
      unsigned char* myidx = sidx + (wave * 32 + tl) * 32;
      if (hf == 0) {
#pragma unroll
        for (int i = 0; i < 16; i++) { myidx[i] = (unsigned char)(127 - (L1[i] & 0x7f)); myidx[16 + i] = (unsigned char)(127 - (L2[i] & 0x7f)); }
      }
      int C[16];
#pragma unroll
      for (int i = 0; i < 16; i++) C[i] = (int)0x80000000;
#pragma unroll
      for (int i = 0; i < 16; i++)
#pragma unroll
        for (int j = 0; j < 16; j++)
          if ((i + 1) * (j + 1) <= 16) {
            int k = (okey(v1[i] + v2[j]) & ~0xff) | (255 - (i * 16 + j));
            ins16(C, k);
          }
      float sv[16];
#pragma unroll
      for (int r = 0; r < 16; r++) sv[r] = okey_val(C[r] & ~0xff);
      float den = 0.f;
      {
        float top = sv[0];
#pragma unroll
        for (int r = 0; r < 16; r++) { sv[r] = __expf(sv[r] - top); den += sv[r]; }
      }
      float rden = 1.f / den;
#pragma unroll
      for (int r = 0; r < 16; r++) {
        if ((r >> 3) == hf) {
          int pos = 255 - (C[r] & 0xff);
          int i1 = myidx[pos >> 4], i2 = myidx[16 + (pos & 15)];
          sel_e[tl * 128 + hh * 16 + r] = i1 * 128 + i2;
          sel_w[tl * 128 + hh * 16 + r] = sv[r] * rden;
        }
      }
    }
    __syncthreads();
    int* nlo_tab = (int*)sidx;
    for (int tt = wave; tt < 32; tt += 4) {
      const int e0_ = sel_e[tt * 128 + lane], e1_ = sel_e[tt * 128 + lane + 64];
      const float w0_ = sel_w[tt * 128 + lane], w1_ = sel_w[tt * 128 + lane + 64];
      const bool lo0 = e0_ < 8192, lo1 = e1_ < 8192;
      const unsigned long long m0 = __ballot(lo0), m1 = __ballot(lo1);
      const unsigned long long lt = (1ull << lane) - 1ull;
      const int c0 = __popcll(m0), c1 = __popcll(m1), nlo = c0 + c1;
      const int p0 = lo0 ? __popcll(m0 & lt) : nlo + __popcll(~m0 & lt);
      const int p1 = lo1 ? c0 + __popcll(m1 & lt) : nlo + (64 - c0) + __popcll(~m1 & lt);
      __builtin_amdgcn_wave_barrier();
      sel_e[tt * 128 + p0] = e0_; sel_e[tt * 128 + p1] = e1_;
      sel_w[tt * 128 + p0] = w0_; sel_w[tt * 128 + p1] = w1_;
      if (lane == 0) nlo_tab[tt] = nlo;
    }
    __builtin_amdgcn_wave_barrier();
    {
    const int tidg_ = opaque_vtid();
    const int lane = tidg_ & 63, wave = tidg_ >> 6;
    const int sub = lane & 15, grp = lane >> 4;
#pragma unroll 1
    for (int upass = 0; upass < 2; upass++)
    for (int tt = wave; tt < 32; tt += 4) {
      const long tok = t0 + tt;
      const int ssp = ((nlo_tab[tt] + 8) >> 4) << 1;
      const int s_beg = upass ? ssp : 0, s_end = upass ? 16 : ssp;
      f32x2 xf[32];
      float sx = 0.f;
#pragma unroll
      for (int c = 0; c < 4; c++) {
#pragma unroll
        for (int h2 = 0; h2 < 2; h2++) {
          uint4 xr = *(const uint4*)(p.XB + tok * 1024 + (sub + 16 * c) * 16 + h2 * 8);
          f32x2* xp = xf + c * 8 + h2 * 4;
          xp[0] = f32x2{bflo(xr.x), bfhi(xr.x)}; xp[1] = f32x2{bflo(xr.y), bfhi(xr.y)};
          xp[2] = f32x2{bflo(xr.z), bfhi(xr.z)}; xp[3] = f32x2{bflo(xr.w), bfhi(xr.w)};
        }
      }
#pragma unroll
      for (int i = 0; i < 32; i++) sx += xf[i].x + xf[i].y;
      sx *= 128.f;
      float dk0 = 0.f, dk1 = 0.f;
      u32x4 bufA[8], bufB[8];
#define ISSUE_U(buf, st)                                                                 \
      _Pragma("unroll") for (int j = 0; j < 2; j++) {                                    \
        const int eidx_ = sel_e[tt * 128 + ((st) * 2 + j) * 4 + grp];                    \
        const unsigned char* ur_ = Ul + (long)eidx_ * 1024 + sub * 16;                   \
        _Pragma("unroll") for (int c = 0; c < 4; c++) buf[j * 4 + c] = *(const u32x4*)(ur_ + c * 256); \
      }
#define COMPUTE_U(buf, st)                                                               \
      _Pragma("unroll") for (int j = 0; j < 2; j++) {                                    \
        f32x2 d2 = f32x2{-sx, 0.f};                                                      \
        _Pragma("unroll") for (int c = 0; c < 4; c++)                                    \
          _Pragma("unroll") for (int w = 0; w < 4; w++) {                                \
            const unsigned q = buf[j * 4 + c][w];                                        \
            d2 += f32x2{(float)(q & 0xffu), (float)((q >> 8) & 0xffu)} * xf[c * 8 + w * 2];      \
            d2 += f32x2{(float)((q >> 16) & 0xffu), (float)(q >> 24)} * xf[c * 8 + w * 2 + 1];   \
          }                                                                              \
        float d = d2.x + d2.y;                                                           \
        d += shx<1>(d); d += shx<2>(d); d += shx<4>(d); d += shx<8>(d); \
        const int it_ = (st) * 2 + j;                                                    \
        if (sub == (it_ & 15)) { if (it_ < 16) dk0 = d; else dk1 = d; }                  \
        __builtin_amdgcn_sched_barrier(0);                                               \
      }
      if (s_beg < s_end) { ISSUE_U(bufA, s_beg) }
      for (int st = s_beg; st < s_end; st += 2) {
        ISSUE_U(bufB, st + 1)
        COMPUTE_U(bufA, st)
        if (st + 2 < s_end) { ISSUE_U(bufA, st + 2) }
        COMPUTE_U(bufB, st + 1)
      }
      {
        const int e0 = sub * 4 + grp, e1 = (16 + sub) * 4 + grp;
        const bool in0 = (sub >= 2 * s_beg) && (sub < 2 * s_end), in1 = (16 + sub >= 2 * s_beg) && (16 + sub < 2 * s_end);
        const int x0 = sel_e[tt * 128 + e0], x1 = sel_e[tt * 128 + e1];
        float d0 = dk0 * SUl[x0], d1 = dk1 * SUl[x1];
        float a0 = 0.5f * d0 * (1.f + erff(d0 * 0.7071067811865476f));
        float a1 = 0.5f * d1 * (1.f + erff(d1 * 0.7071067811865476f));
        if (in0) sel_w[tt * 128 + e0] = a0 * sel_w[tt * 128 + e0] * SVl[x0];
        if (in1) sel_w[tt * 128 + e1] = a1 * sel_w[tt * 128 + e1] * SVl[x1];
      }
    }
#pragma unroll 1
    for (int hsel = 0; hsel < 2; hsel++) {
      f32x2 accT[4][8];
      float csumT[4];
#pragma unroll
      for (int ti = 0; ti < 4; ti++) {
        csumT[ti] = 0.f;
#pragma unroll
        for (int i = 0; i < 8; i++) accT[ti][i] = f32x2{0.f, 0.f};
      }
#define ISSUE_V(buf, tt_, st)                                                            \
      _Pragma("unroll") for (int j = 0; j < 8; j++) {                                    \
        const int eidx_ = __builtin_amdgcn_readfirstlane(sel_e[(tt_) * 128 + (st) * 8 + j]); \
        buf[j] = *(const u32x4*)(Vl + (long)eidx_ * 1024 + (unsigned)(lane * 16));       \
      }
#define COMPUTE_V(buf, ti, tt_, st)                                                      \
      _Pragma("unroll") for (int j = 0; j < 8; j++) {                                    \
        const float c_ = sel_w[(tt_) * 128 + (st) * 8 + j];                              \
        csumT[ti] += c_;                                                                 \
        const f32x2 c2 = f32x2{c_, c_};                                                  \
        _Pragma("unroll") for (int w = 0; w < 4; w++) {                                  \
          const unsigned q = buf[j][w];                                                  \
          accT[ti][w * 2] += c2 * f32x2{(float)(q & 0xffu), (float)((q >> 8) & 0xffu)};  \
          accT[ti][w * 2 + 1] += c2 * f32x2{(float)((q >> 16) & 0xffu), (float)(q >> 24)}; \
        }                                                                                \
        if (j & 1) __builtin_amdgcn_sched_barrier(0);                                    \
      }
#pragma unroll 1
      for (int vpass = 0; vpass < 2; vpass++) {
#pragma unroll
        for (int ti = 0; ti < 4; ti++) {
          const int tt = wave + 4 * (hsel * 4 + ti);
          const int ssp = ((nlo_tab[tt] + 8) >> 4) << 1;
          const int c_beg = vpass ? ssp : 0, c_end = vpass ? 16 : ssp;
          u32x4 bufA[8], bufB[8];
          if (c_beg < c_end) { ISSUE_V(bufA, tt, c_beg) }
#pragma unroll 1
          for (int st = c_beg; st < c_end; st += 2) {
            ISSUE_V(bufB, tt, st + 1)
            COMPUTE_V(bufA, ti, tt, st)
            if (st + 2 < c_end) { ISSUE_V(bufA, tt, st + 2) }
            COMPUTE_V(bufB, ti, tt, st + 1)
          }
        }
      }
      peer_finish_token(p, l, last, t0 + wave + 4 * (hsel * 4 + 0), accT[0], csumT[0], lane);
      peer_finish_token(p, l, last, t0 + wave + 4 * (hsel * 4 + 1), accT[1], csumT[1], lane);
      peer_finish_token(p, l, last, t0 + wave + 4 * (hsel * 4 + 2), accT[2], csumT[2], lane);
      peer_finish_token(p, l, last, t0 + wave + 4 * (hsel * 4 + 3), accT[3], csumT[3], lane);
    }
    }
  }
}


#define XB_TMO      128
#define XB_XCNT(j)  (256  + 64 * (j))
#define XB_XSUB(j)  (1280 + 64 * (j))
#define XB_XGEN(j)  (2304 + 64 * (j))
#define XB_TOP      3328
#define XB_TOPGEN   3392
#define XB_CENSUS   3456
#define XCD_BAR_WORDS 3472
#define XB_SPIN_CAP (1u << 22)
DI unsigned xb_ld(unsigned* p) { return __hip_atomic_load(p, __ATOMIC_RELAXED, __HIP_MEMORY_SCOPE_AGENT); }
DI unsigned xb_add(unsigned* p, unsigned v) { return __hip_atomic_fetch_add(p, v, __ATOMIC_RELAXED, __HIP_MEMORY_SCOPE_AGENT); }
DI unsigned xb_xcc_id() { return (unsigned)__builtin_amdgcn_s_getreg((3 << 11) | 20) & 0xFu; }
#define XB_SPIN(cond, bar) do { unsigned _sp = 0; while (cond) { __builtin_amdgcn_s_sleep(1); \
    if ((++_sp & 255u) == 0u) { if (xb_ld(&(bar)[XB_TMO])) break; if (_sp > XB_SPIN_CAP) { atomicAdd(&(bar)[XB_TMO], 1u); break; } } } } while (0)
struct XcdBarrier { unsigned* bar; unsigned x; volatile LAS unsigned* st; };
DI volatile LAS unsigned* xb_state() { __shared__ uint4 xb_words_; return (volatile LAS unsigned*)&xb_words_; }
DI XcdBarrier xcd_barrier_post(unsigned* bar, volatile LAS unsigned* st) {
  XcdBarrier b; b.bar = bar; b.x = xb_xcc_id(); b.st = st;
  if (threadIdx.x == 0) (void)xb_add(&bar[XB_XCNT(b.x)], 1u);
  return b;
}
DI void xcd_barrier_complete(unsigned* bar, unsigned x, unsigned& nloc, unsigned& nx) {
  const unsigned G = gridDim.x;
  unsigned sum, cnt, mine, sp = 0u;
  for (;;) {
    sum = 0u; cnt = 0u; mine = 0u;
#pragma unroll
    for (unsigned j = 0; j < 16; ++j) { const unsigned c = xb_ld(&bar[XB_XCNT(j)]); sum += c; cnt += (c > 0u) ? 1u : 0u; mine = (j == x) ? c : mine; }
    if (sum == G) break;
    __builtin_amdgcn_s_sleep(1);
    if ((++sp & 255u) == 0u) { if (xb_ld(&bar[XB_TMO])) break; if (sp > XB_SPIN_CAP) { atomicAdd(&bar[XB_TMO], 1u); break; } }
  }
  nloc = mine > 0u ? mine : 1u; nx = cnt > 0u ? cnt : 1u;
}
DI void xcd_barrier(unsigned* bar_, volatile LAS unsigned* st_) {
  XcdBarrier b; b.bar = bar_; b.st = st_; b.x = xb_xcc_id();
  asm volatile("s_waitcnt vmcnt(0)" ::: "memory");
  __syncthreads();
  if (opaque_tid() == 0) {
    unsigned* bar = b.bar;
    __builtin_amdgcn_s_waitcnt(0);
    unsigned nloc = b.st[0], nx = b.st[1];
    if (nloc == 0u) { xcd_barrier_complete(bar, b.x, nloc, nx); b.st[0] = nloc; b.st[1] = nx; }
    const unsigned old = xb_add(&bar[XB_XSUB(b.x)], 1u);
    const unsigned gen = old / nloc;
    if (old + 1u == (gen + 1u) * nloc) {
      __builtin_amdgcn_fence(__ATOMIC_RELEASE, "agent");
      asm volatile("s_waitcnt vmcnt(0)" ::: "memory");
      const unsigned og = xb_add(&bar[XB_TOP], 1u);
      const unsigned tg = og / nx;
      if (og + 1u == (tg + 1u) * nx) xb_add(&bar[XB_TOPGEN], 1u);
      else XB_SPIN(xb_ld(&bar[XB_TOPGEN]) == tg, bar);
      __builtin_amdgcn_fence(__ATOMIC_ACQUIRE, "agent");
      xb_add(&bar[XB_XGEN(b.x)], 1u);
      asm volatile("s_waitcnt vmcnt(0)" ::: "memory");
    } else {
      XB_SPIN(xb_ld(&bar[XB_XGEN(b.x)]) == gen, bar);
      __builtin_amdgcn_fence(__ATOMIC_ACQUIRE, "agent");
      asm volatile("s_waitcnt vmcnt(0)" ::: "memory");
    }
  }
  __syncthreads();
}

#ifndef REP
#define REP -1
#endif
#define BAR() xcd_barrier(p.BAR, xb_state())
#define RUNPH(k, call) do { call; if (REP == (k)) { BAR(); call; } } while (0)
__global__ void __launch_bounds__(NTHR, 2) mega_kernel(P p) {
  extern __shared__ __attribute__((aligned(1024))) char smem[];
  __shared__ int xc_sh[2];
  const int bid = blockIdx.x, nb = gridDim.x;
  if (threadIdx.x == 0) { volatile LAS unsigned* st = xb_state(); st[0] = 0u; st[1] = 0u; st[2] = 0u; st[3] = 0u; }
  if ((threadIdx.x & 63) == 0) wmap()[hw_slot()] = (int)(threadIdx.x >> 6);
  __syncthreads();
  (void)xcd_barrier_post(p.BAR, xb_state());
  if (threadIdx.x == 0) { const unsigned x = xb_xcc_id() & 7u; xc_sh[0] = (int)x; xc_sh[1] = (int)xb_add(&p.BAR[XB_CENSUS + x], 1u); }
  __syncthreads();
  const int vb = __builtin_amdgcn_readfirstlane((int)threadIdx.x >> 8);
  const int vbid = bid * 2 + vb, vnb = nb * 2;
  char* vsmem = smem + vb * VSMEM;
  RUNPH(0, ph_prep(p, vsmem, vbid, vnb));
  BAR();
  Xcd xc;
  xc.id = __builtin_amdgcn_readfirstlane(xc_sh[0]); xc.slot = __builtin_amdgcn_readfirstlane(xc_sh[1]);
  xc.n = __builtin_amdgcn_readfirstlane((int)xb_ld(&p.BAR[XB_CENSUS + xc.id]));
#pragma unroll 1
  for (int l = 0; l < 2; l++) {
    RUNPH(1, ph_inproj(p, l, smem, bid, nb, xc));
    BAR();
    ph_fftA(p, smem, bid, nb);
    RUNPH(2, ph_attn(p, l, vsmem, xc, vb));
    BAR();
    RUNPH(3, ph_fftC(p, smem, bid, nb));
    BAR();
    RUNPH(4, ph_branch(p, l, smem, bid, nb, xc));
    BAR();
    RUNPH(5, ph_outproj(p, l, smem, bid, nb, xc));
    BAR();
    RUNPH(6, ph_ln1(p, l, vbid, vnb));
    BAR();
    RUNPH(7, ph_peerq(p, l, smem, bid, nb, xc));
    BAR();
    if (REP == 8) { ph_peer(p, l, vsmem, vbid, vnb, true); BAR(); }
    ph_peer(p, l, vsmem, vbid, vnb, l == 1);
    if (l == 0) BAR();
  }
}

extern "C" void kernel_launch(void* const* d_in, const int* in_sizes, int n_in, void* d_out, int out_size,
                              void* d_ws, size_t ws_size, hipStream_t stream) {
  P p{};
  p.x = (const float*)d_in[0]; p.ln0g = (const float*)d_in[1]; p.ln0b = (const float*)d_in[2];
  p.w_in = (const float*)d_in[3]; p.b_gate = (const float*)d_in[4]; p.qng = (const float*)d_in[5]; p.kng = (const float*)d_in[6];
  p.w_bf = (const float*)d_in[7]; p.w_ba = (const float*)d_in[8]; p.w_out = (const float*)d_in[9];
  p.ln1g = (const float*)d_in[10]; p.ln1b = (const float*)d_in[11]; p.w_q = (const float*)d_in[12]; p.sk = (const float*)d_in[13];
  p.pu = (const float*)d_in[14]; p.pv = (const float*)d_in[15]; p.ln2g = (const float*)d_in[16]; p.ln2b = (const float*)d_in[17];
  p.out = (float*)d_out;
  char* w = (char*)d_ws;
  size_t off = 0;
  auto take = [&](size_t bytes) { char* r = w + off; off += (bytes + 255) & ~(size_t)255; return r; };
  p.WIN = (u16*)take((size_t)2 * 3328 * 1024 * 2);
  p.WBF = (u16*)take((size_t)2 * 1024 * 512 * 2);
  p.WBA = (u16*)take((size_t)2 * 1024 * 512 * 2);
  p.WOUT = (u16*)take((size_t)2 * 1024 * 1024 * 2);
  p.WQ = (u16*)take((size_t)2 * 2048 * 1024 * 2);
  p.SK = (u16*)take((size_t)2 * 8 * 2 * 128 * 128 * 2);
  p.U8 = (unsigned char*)take((size_t)2 * 16384 * 1024);
  p.V8 = (unsigned char*)take((size_t)2 * 16384 * 1024);
  p.SU = (float*)take((size_t)2 * 16384 * 4);
  p.SV = (float*)take((size_t)2 * 16384 * 4);
  p.D256 = (u16*)take(256 * 256 * 2);
  p.C64 = (u16*)take(64 * 128 * 2);
  p.TW = (float2*)take(128 * 64 * 8);
  p.ROPE = (float2*)take(128 * 16 * 8);
  p.XS = (float*)take((size_t)T * 1024 * 4);
  p.XB = (u16*)take((size_t)T * 1024 * 2);
  p.ZT = (u16*)take((size_t)33280 * 256 * 2);
  p.GP = (u16*)take((size_t)66560 * 128 * 2);
  p.Y = (u16*)take((size_t)T * 512 * 2);
  p.Q = (u16*)take((size_t)T * 512 * 2);
  p.K = (u16*)take((size_t)T * 128 * 2);
  p.VT = (u16*)take((size_t)T * 128 * 2);
  p.AO = (u16*)take((size_t)T * 512 * 2);
  p.GATES = (u16*)take((size_t)T * 2048 * 2);
  p.QP = p.GATES;
  p.MIXED = (u16*)take((size_t)T * 1024 * 2);
  p.BAR = (unsigned*)take(XCD_BAR_WORDS * 4);
  if (off > ws_size) { fprintf(stderr, "workspace too small: need %zu have %zu\n", off, ws_size); return; }

  static int grid_blocks = 0;
  if (!grid_blocks) {
    int dev = 0, cus = 0, per_cu = 0;
    (void)hipGetDevice(&dev);
    (void)hipDeviceGetAttribute(&cus, hipDeviceAttributeMultiprocessorCount, dev);
    (void)hipFuncSetAttribute((const void*)mega_kernel, hipFuncAttributeMaxDynamicSharedMemorySize, SMEM_BYTES);
    (void)hipOccupancyMaxActiveBlocksPerMultiprocessor(&per_cu, mega_kernel, NTHR, SMEM_BYTES);
    if (per_cu < 1) per_cu = 1;
    grid_blocks = cus;
  }
  (void)hipMemsetAsync(p.BAR, 0, XCD_BAR_WORDS * 4, stream);
  void* args[] = {&p};
  hipError_t e = hipLaunchCooperativeKernel((void*)mega_kernel, dim3(grid_blocks), dim3(NTHR), args, SMEM_BYTES, stream);
  if (e != hipSuccess) fprintf(stderr, "cooperative launch failed: %s (grid %d)\n", hipGetErrorString(e), grid_blocks);
}
```

```cpp
#include <hip/hip_runtime.h>
#include <hip/hip_cooperative_groups.h>
#include <cstdio>
namespace cg = cooperative_groups;


typedef unsigned short u16;
using bf16x8 = __attribute__((ext_vector_type(8))) short;
using s16x4  = __attribute__((ext_vector_type(4))) short;
using f32x16 = __attribute__((ext_vector_type(16))) float;
using u32x4  = __attribute__((ext_vector_type(4))) unsigned;
using f32x2  = __attribute__((ext_vector_type(2))) float;
#define DI __device__ __forceinline__
#define MFMA(a, b, c) __builtin_amdgcn_mfma_f32_32x32x16_bf16((a), (b), (c), 0, 0, 0)

constexpr int T = 16384;
constexpr float ALPHA = 1.4142135623730951f;
constexpr int NTHR = 512;
constexpr int VSMEM = 73728;
constexpr int SMEM_BYTES = 2 * VSMEM;

struct P {
  const float *x, *ln0g, *ln0b, *w_in, *b_gate, *qng, *kng, *w_bf, *w_ba, *w_out, *ln1g, *ln1b, *w_q, *sk, *pu, *pv, *ln2g, *ln2b;
  float* out;
  u16 *WIN, *WBF, *WBA, *WOUT, *WQ, *SK, *D256, *C64;
  float2 *TW, *ROPE;
  float* XS;
  u16 *XB, *ZT, *GP, *Y, *Q, *K, *VT, *AO, *GATES, *MIXED, *QP;
  unsigned* BAR;
  unsigned char *U8, *V8;
  float *SU, *SV;
};

DI u16 f2bf(float f) { __bf16 h = (__bf16)f; return __builtin_bit_cast(u16, h); }
DI float bf2f(u16 h) { return __uint_as_float(((unsigned)h) << 16); }
DI unsigned pack2(float a, float b) { return (unsigned)f2bf(a) | ((unsigned)f2bf(b) << 16); }
DI float bflo(unsigned u) { return __uint_as_float(u << 16); }
DI float bfhi(unsigned u) { return __uint_as_float(u & 0xffff0000u); }
#define LAS __attribute__((address_space(3)))
DI int hw_slot() { return __builtin_amdgcn_s_getreg((5 << 11) | 4) & 63; }
DI volatile LAS int* wmap() { __shared__ int wm_[64]; return (volatile LAS int*)wm_; }
DI int lane_id() { int l; asm volatile("v_mbcnt_lo_u32_b32 %0, -1, 0\n\tv_mbcnt_hi_u32_b32 %0, -1, %0" : "=&v"(l)); return l; }
DI int opaque_tid() { int w = wmap()[hw_slot()]; int t = (w << 6) | lane_id(); asm volatile("" : "+v"(t)); return t; }
DI int opaque_vtid() { return opaque_tid() & 255; }
template <int M> DI int shxi(int v) {
  if constexpr (M < 32) return __builtin_amdgcn_ds_swizzle(v, (M << 10) | 0x1f);
  else { int a = (lane_id() ^ 32) << 2; asm volatile("" : "+v"(a)); return __builtin_amdgcn_ds_bpermute(a, v); }
}
template <int M> DI float shx(float v) { return __int_as_float(shxi<M>(__float_as_int(v))); }
DI float wave_sum(float v) {
  v += shx<32>(v); v += shx<16>(v); v += shx<8>(v); v += shx<4>(v); v += shx<2>(v); v += shx<1>(v);
  return v;
}

template <int MT>
DI void gemm_main(const u16* __restrict__ A, long lda, const u16* __restrict__ B, long ldb, int K,
                  f32x16 (&acc)[MT][2], char* smem, const int  , const int rot = 0) {
  constexpr int STAGE = (64 * MT + 256) * 72;
  u16* s0 = (u16*)smem;
  const int tid = opaque_tid();
  const int lane = tid & 63, wave = tid >> 6;
  const int wm = wave >> 2, wn = wave & 3;
  const int lr = tid >> 3, lc = (tid & 7) * 8;
  const u16* Ap = A + (long)lr * lda + lc;
  const u16* Bp = B + (long)lr * ldb + lc;
  u32x4 ra[MT], rb[4];
  const int nk = K >> 6;
#define G_LOAD(kt)                                                                                      \
  _Pragma("unroll") for (int c = 0; c < MT; c++) ra[c] = *(const u32x4*)(Ap + (long)(64 * c) * lda + (((kt) + rot) & (nk - 1)) * 64); \
  _Pragma("unroll") for (int c = 0; c < 4; c++) rb[c] = *(const u32x4*)(Bp + (long)(64 * c) * ldb + (((kt) + rot) & (nk - 1)) * 64);
#define G_STORE(st)                                                                                     \
  { u16* sA_ = s0 + (st) * STAGE; u16* sB_ = sA_ + 64 * MT * 72;                                        \
    _Pragma("unroll") for (int c = 0; c < MT; c++) *(u32x4*)(sA_ + (lr + 64 * c) * 72 + lc) = ra[c];    \
    _Pragma("unroll") for (int c = 0; c < 4; c++) *(u32x4*)(sB_ + (lr + 64 * c) * 72 + lc) = rb[c]; }
#define G_COMPUTE(st)                                                                                   \
  { const u16* sA_ = s0 + (st) * STAGE; const u16* sB_ = sA_ + 64 * MT * 72;                            \
    _Pragma("unroll") for (int kk = 0; kk < 4; kk++) {                                                  \
      bf16x8 af[MT], bfr[2];                                                                            \
      _Pragma("unroll") for (int i = 0; i < MT; i++) af[i] = *(const bf16x8*)(sA_ + (wm * 32 * MT + i * 32 + (lane & 31)) * 72 + kk * 16 + (lane >> 5) * 8); \
      _Pragma("unroll") for (int j = 0; j < 2; j++) bfr[j] = *(const bf16x8*)(sB_ + (wn * 64 + j * 32 + (lane & 31)) * 72 + kk * 16 + (lane >> 5) * 8);     \
      _Pragma("unroll") for (int i = 0; i < MT; i++)                                                    \
        _Pragma("unroll") for (int j = 0; j < 2; j++) acc[i][j] = MFMA(af[i], bfr[j], acc[i][j]);       \
      if (MT > 2) __builtin_amdgcn_sched_barrier(0);                                                    \
    } }
  G_LOAD(0)
  __syncthreads();
  G_STORE(0)
  G_LOAD((1 < nk ? 1 : 0))
  __syncthreads();
  const bool late = __builtin_amdgcn_readfirstlane(wave) >= 4;
  for (int t = 0; t < nk; t++) {
    if (!late) {
      if (t + 1 < nk) { G_STORE((t + 1) & 1) }
      if (t + 2 < nk) { G_LOAD(t + 2) }
    }
    __builtin_amdgcn_s_setprio(1);
    G_COMPUTE(t & 1)
    __builtin_amdgcn_s_setprio(0);
    if (late) {
      if (t + 1 < nk) { G_STORE((t + 1) & 1) }
      if (t + 2 < nk) { G_LOAD(t + 2) }
    }
    __syncthreads();
  }
#undef G_LOAD
#undef G_STORE
#undef G_COMPUTE
}

struct Xcd { int id, slot, n; };
#define XCD_TILE_LOOP(MTOT, NTOT, mt, nt)                                             \
  for (int j_ = xc.slot, mt, nt; j_ < ((MTOT) / 8) * (NTOT) && (mt = xc.id * ((MTOT) / 8) + j_ % ((MTOT) / 8), nt = j_ / ((MTOT) / 8), true); j_ += xc.n)

template <int MT>
DI void zero_acc(f32x16 (&acc)[MT][2]) {
#pragma unroll
  for (int i = 0; i < MT; i++)
#pragma unroll
    for (int j = 0; j < 2; j++)
#pragma unroll
      for (int r = 0; r < 16; r++) acc[i][j][r] = 0.f;
}

DI void stage_q(f32x16 (&acc)[4][2], float* sC, const int tid, const int mh, const int nh) {
  const int lane = tid & 63, wave = tid >> 6, wm = wave >> 2, wn = wave & 3;
  if (wm == mh && (wn >> 1) == nh) {
#pragma unroll
    for (int i = 0; i < 4; i++)
#pragma unroll
      for (int j = 0; j < 2; j++)
#pragma unroll
        for (int r = 0; r < 16; r++) {
          int row = i * 32 + 8 * (r >> 2) + 4 * (lane >> 5) + (r & 3);
          int col = (wn & 1) * 64 + j * 32 + (lane & 31);
          sC[row * 132 + col] = acc[i][j][r];
        }
  }
  __syncthreads();
}
DI void stage_q_tr(f32x16 (&acc)[4][2], float* sC, const int tid, const int mh, const int nh) {
  const int lane = tid & 63, wave = tid >> 6, wm = wave >> 2, wn = wave & 3;
  if (wm == mh && (wn >> 1) == nh) {
#pragma unroll
    for (int i = 0; i < 4; i++)
#pragma unroll
      for (int j = 0; j < 2; j++)
#pragma unroll
        for (int rq = 0; rq < 4; rq++) {
          int row = i * 32 + 8 * rq + 4 * (lane >> 5);
          int col = (wn & 1) * 64 + j * 32 + (lane & 31);
          float4 v = make_float4(acc[i][j][rq * 4], acc[i][j][rq * 4 + 1], acc[i][j][rq * 4 + 2], acc[i][j][rq * 4 + 3]);
          *(float4*)(sC + col * 132 + row) = v;
        }
  }
  __syncthreads();
}
DI void unstage_q(f32x16 (&acc)[4][2], const float* sC, const int tid, const int mh, const int nh) {
  const int lane = tid & 63, wave = tid >> 6, wm = wave >> 2, wn = wave & 3;
  if (wm == mh && (wn >> 1) == nh) {
#pragma unroll
    for (int i = 0; i < 4; i++)
#pragma unroll
      for (int j = 0; j < 2; j++)
#pragma unroll
        for (int r = 0; r < 16; r++) {
          int row = i * 32 + 8 * (r >> 2) + 4 * (lane >> 5) + (r & 3);
          int col = (wn & 1) * 64 + j * 32 + (lane & 31);
          acc[i][j][r] = sC[row * 132 + col];
        }
  }
  __syncthreads();
}
DI void stage_h1(f32x16 (&acc)[1][2], float* sC, const int tid, const int nh) {
  const int lane = tid & 63, wave = tid >> 6, wm = wave >> 2, wn = wave & 3;
  if ((wn >> 1) == nh) {
#pragma unroll
    for (int j = 0; j < 2; j++)
#pragma unroll
      for (int r = 0; r < 16; r++) {
        int row = wm * 32 + 8 * (r >> 2) + 4 * (lane >> 5) + (r & 3);
        int col = (wn & 1) * 64 + j * 32 + (lane & 31);
        sC[row * 132 + col] = acc[0][j][r];
      }
  }
  __syncthreads();
}

DI void ln16_write(float (&v)[16], const float* g, const float* bt, float* dstf, u16* dstb, int lane) {
  float s = 0.f;
#pragma unroll
  for (int i = 0; i < 16; i++) s += v[i];
  float mu = wave_sum(s) * (1.f / 1024.f);
  float q = 0.f;
#pragma unroll
  for (int i = 0; i < 16; i++) { float d = v[i] - mu; q += d * d; }
  float rstd = rsqrtf(wave_sum(q) * (1.f / 1024.f) + 1e-5f);
#pragma unroll
  for (int c = 0; c < 4; c++) {
    int e = (lane + 64 * c) * 4;
    float4 gg = *(const float4*)(g + e), bb = *(const float4*)(bt + e);
    float4 o;
    o.x = (v[c * 4 + 0] - mu) * rstd * gg.x + bb.x;
    o.y = (v[c * 4 + 1] - mu) * rstd * gg.y + bb.y;
    o.z = (v[c * 4 + 2] - mu) * rstd * gg.z + bb.z;
    o.w = (v[c * 4 + 3] - mu) * rstd * gg.w + bb.w;
    if (dstf) *(float4*)(dstf + e) = o;
    if (dstb) { uint2 pk; pk.x = pack2(o.x, o.y); pk.y = pack2(o.z, o.w); *(uint2*)(dstb + e) = pk; }
  }
}

DI void transpose_tile(const float* __restrict__ src, int ldsrc, u16* __restrict__ dst, int lddst, float* tile  , const int tid, const bool act) {
  __syncthreads();
#pragma unroll
  for (int i = 0; i < 4; i++) {
    int r = (tid >> 4) + 16 * i, c4 = (tid & 15) * 4;
    float4 v = *(const float4*)(src + (long)r * ldsrc + c4);
    tile[r * 65 + c4] = v.x; tile[r * 65 + c4 + 1] = v.y; tile[r * 65 + c4 + 2] = v.z; tile[r * 65 + c4 + 3] = v.w;
  }
  __syncthreads();
#pragma unroll
  for (int i = 0; i < 2; i++) {
    int unit = tid + 256 * i, n = unit >> 3, ch = unit & 7;
    uint4 o;
    o.x = pack2(tile[(ch * 8 + 0) * 65 + n], tile[(ch * 8 + 1) * 65 + n]);
    o.y = pack2(tile[(ch * 8 + 2) * 65 + n], tile[(ch * 8 + 3) * 65 + n]);
    o.z = pack2(tile[(ch * 8 + 4) * 65 + n], tile[(ch * 8 + 5) * 65 + n]);
    o.w = pack2(tile[(ch * 8 + 6) * 65 + n], tile[(ch * 8 + 7) * 65 + n]);
    if (act) *(uint4*)(dst + (long)n * lddst + ch * 8) = o;
  }
}

DI void ph_prep(const P& p, char* smem, int bid, int nb) {
  constexpr int VT = 256;
  const int tid = opaque_vtid(), lane = tid & 63, wave = tid >> 6;
  for (int row = bid * 4 + wave; row < T; row += nb * 4) {
    const float* src = p.x + (long)row * 1024;
    float v[16];
#pragma unroll
    for (int c = 0; c < 4; c++) { float4 t = *(const float4*)(src + (lane + 64 * c) * 4); v[c * 4] = t.x; v[c * 4 + 1] = t.y; v[c * 4 + 2] = t.z; v[c * 4 + 3] = t.w; }
    int b = row >> 13, s = row & 8191;
    int tp = (b << 13) + (s & 63) * 128 + (s >> 6);
    ln16_write(v, p.ln0g, p.ln0b, p.XS + (long)tp * 1024, p.XB + (long)tp * 1024, lane);
  }
  for (int r = bid * 4 + wave; r < 65536; r += nb * 4) {
    const int tb = r >> 15, rr = r & 32767;
    const float* src = (tb ? p.pv : p.pu) + (long)rr * 1024;
    float v[16];
#pragma unroll
    for (int c = 0; c < 4; c++) { float4 t = *(const float4*)(src + (lane + 64 * c) * 4); v[c * 4] = t.x; v[c * 4 + 1] = t.y; v[c * 4 + 2] = t.z; v[c * 4 + 3] = t.w; }
    float am = 0.f;
#pragma unroll
    for (int i = 0; i < 16; i++) am = fmaxf(am, fabsf(v[i]));
    { am = fmaxf(am, shx<32>(am)); am = fmaxf(am, shx<16>(am)); am = fmaxf(am, shx<8>(am)); am = fmaxf(am, shx<4>(am)); am = fmaxf(am, shx<2>(am)); am = fmaxf(am, shx<1>(am)); }
    const float inv = am > 0.f ? 127.f / am : 0.f;
    unsigned char* dst = (tb ? p.V8 : p.U8) + (long)rr * 1024;
#pragma unroll
    for (int c = 0; c < 4; c++) {
      unsigned q0 = (unsigned)((int)rintf(v[c * 4] * inv) + 128), q1 = (unsigned)((int)rintf(v[c * 4 + 1] * inv) + 128);
      unsigned q2 = (unsigned)((int)rintf(v[c * 4 + 2] * inv) + 128), q3 = (unsigned)((int)rintf(v[c * 4 + 3] * inv) + 128);
      *(unsigned*)(dst + (lane + 64 * c) * 4) = q0 | (q1 << 8) | (q2 << 16) | (q3 << 24);
    }
    if (lane == 0) (tb ? p.SV : p.SU)[rr] = am * (1.f / 127.f);
  }
  for (int i = bid * VT + tid; i < 2 * 8 * 2 * 128 * 128 / 8; i += nb * VT) {
    const float* s = p.sk + (long)i * 8;
    float4 a = *(const float4*)s, b = *(const float4*)(s + 4);
    uint4 o; o.x = pack2(a.x, a.y); o.y = pack2(a.z, a.w); o.z = pack2(b.x, b.y); o.w = pack2(b.z, b.w);
    *(uint4*)(p.SK + (long)i * 8) = o;
  }
  {
    float* tile = (float*)smem;
    const int per_layer = 704 + 128 + 128 + 256 + 512;
    for (int it0 = 0; it0 < 2 * per_layer; it0 += nb) {
      int it = it0 + bid; const bool act = it < 2 * per_layer; if (!act) it = 0;
      int l = it / per_layer, r = it % per_layer;
      const float* src; u16* dst; int ldsrc, lddst, kt, nt;
      if (r < 704) { kt = r / 44; nt = r % 44; src = p.w_in + (long)l * 1024 * 3328 + 512; ldsrc = 3328; dst = p.WIN + ((long)l * 3328 + 512) * 1024; lddst = 1024; }
      else if (r < 832) { r -= 704; kt = r / 16; nt = r % 16; src = p.w_bf + (long)l * 512 * 1024; ldsrc = 1024; dst = p.WBF + (long)l * 1024 * 512; lddst = 512; }
      else if (r < 960) { r -= 832; kt = r / 16; nt = r % 16; src = p.w_ba + (long)l * 512 * 1024; ldsrc = 1024; dst = p.WBA + (long)l * 1024 * 512; lddst = 512; }
      else if (r < 1216) { r -= 960; kt = r / 16; nt = r % 16; src = p.w_out + (long)l * 1024 * 1024; ldsrc = 1024; dst = p.WOUT + (long)l * 1024 * 1024; lddst = 1024; }
      else { r -= 1216; kt = r / 32; nt = r % 32; src = p.w_q + (long)l * 1024 * 2048; ldsrc = 2048; dst = p.WQ + (long)l * 2048 * 1024; lddst = 1024; }
      transpose_tile(src + (long)kt * 64 * ldsrc + nt * 64, ldsrc, dst + (long)nt * 64 * lddst + kt * 64, lddst, tile, tid, act);
    }
    __syncthreads();
  }
  {
    float* wt = (float*)smem;
    float* ctab = wt + 16 * 128;
    if (tid < 128) ctab[tid] = cospif((float)tid / 64.f);
    for (int it0 = 0; it0 < 2 * 4 * 64; it0 += nb) {
      int it = it0 + bid; const bool act = it < 2 * 4 * 64; if (!act) it = 0;
      int l = it >> 8, g = (it >> 6) & 3, kt = it & 63;
      __syncthreads();
      for (int e = tid; e < 16 * 32; e += VT) {
        int kr = e >> 5, c4 = (e & 31) * 4;
        *(float4*)(wt + kr * 128 + c4) = *(const float4*)(p.w_in + ((long)l * 1024 + kt * 16 + kr) * 3328 + g * 128 + c4);
      }
      __syncthreads();
      int j = tid & 127, kh = tid >> 7;
      int cp, off; float sgn;
      if (j < 65) { cp = j; off = 0; sgn = 0.08838834764831845f; } else { cp = j - 64; off = 96; sgn = -0.08838834764831845f; }
      float a[8];
#pragma unroll
      for (int q = 0; q < 8; q++) a[q] = 0.f;
      for (int d = 0; d < 128; d++) {
        float bs = ctab[(cp * d + off) & 127];
#pragma unroll
        for (int q = 0; q < 8; q++) a[q] += wt[(kh * 8 + q) * 128 + d] * bs;
      }
      uint4 o; o.x = pack2(a[0] * sgn, a[1] * sgn); o.y = pack2(a[2] * sgn, a[3] * sgn); o.z = pack2(a[4] * sgn, a[5] * sgn); o.w = pack2(a[6] * sgn, a[7] * sgn);
      if (act) *(uint4*)(p.WIN + ((long)l * 3328 + g * 128 + j) * 1024 + kt * 16 + kh * 8) = o;
    }
    __syncthreads();
  }
  for (int i = bid * VT + tid; i < 65536; i += nb * VT) {
    int m = i >> 8, kk = i & 255;
    int mh = m >> 7, po = (m >> 6) & 1, k1 = mh * 64 + (m & 63);
    int pi = kk >> 7, s1 = kk & 127;
    int a = (k1 * s1) & 127;
    float c = cospif((float)a / 64.f), s = sinpif((float)a / 64.f);
    float v = (po == pi) ? c : (po == 0 ? s : -s);
    p.D256[i] = f2bf(v * 0.08838834764831845f);
  }
  for (int i = bid * VT + tid; i < 8192; i += nb * VT) {
    int k2 = i >> 7, kk = i & 127, pi = kk >> 6, s2 = kk & 63;
    int a = (k2 * s2) & 63;
    float v = pi ? sinpif((float)a / 32.f) : cospif((float)a / 32.f);
    p.C64[i] = f2bf(v * 0.125f);
    int k1 = i >> 6, t2 = i & 63;
    float ph = (float)(k1 * t2) / 4096.f;
    p.TW[i] = make_float2(cospif(ph), sinpif(ph));
  }
  for (int i = bid * VT + tid; i < 2048; i += nb * VT) {
    int pos = i >> 4, f = i & 15;
    float inv = 1.0f / powf(10000.f, (float)(2 * f) / 32.f);
    float ang = (float)pos * inv;
    p.ROPE[i] = make_float2(cosf(ang), sinf(ang));
  }
}

DI void inproj_epi_fourier(const P& p, const float* sC, int mt, int g, const int tid) {
  const int b = mt >> 6, s2 = mt & 63;
#pragma unroll 1
  for (int unit = tid; unit < 2048; unit += NTHR) {
    int j = unit >> 4, ch = unit & 15;
    float4 a = *(const float4*)(sC + j * 132 + ch * 8), c = *(const float4*)(sC + j * 132 + ch * 8 + 4);
    uint4 o; o.x = pack2(a.x, a.y); o.y = pack2(a.z, a.w); o.z = pack2(c.x, c.y); o.w = pack2(c.z, c.w);
    int cp = (j < 65) ? j : j - 64, part = (j < 65) ? 0 : 1;
    long rowi = ((long)(b * 4 + g) * 65 + cp) * 64 + s2;
    *(uint4*)(p.ZT + rowi * 256 + part * 128 + ch * 8) = o;
  }
  if (tid < 32) {
    int cp = (tid < 16) ? 0 : 64, ch = tid & 15;
    long rowi = ((long)(b * 4 + g) * 65 + cp) * 64 + s2;
    unsigned z_; asm volatile("v_mov_b32 %0, 0" : "=v"(z_));
    *(uint4*)(p.ZT + rowi * 256 + 128 + ch * 8) = make_uint4(z_, z_, z_, z_);
  }
}
DI void inproj_epi_qk(const P& p, int l, const float* sC, int mt, int nt, const int tid) {
  const int b = mt >> 6, s2 = mt & 63;
  if (tid < 256) {
    const int row = tid & 127, hd = tid >> 7;
    const float* sr = sC + row * 132 + hd * 64;
    float ss = 0.f;
#pragma unroll
    for (int i = 0; i < 16; i++) { float4 t = *(const float4*)(sr + i * 4); ss += t.x * t.x + t.y * t.y + t.z * t.z + t.w * t.w; }
    const bool isq = nt < 8;
    const float* gn = (isq ? p.qng : p.kng) + l * 64;
    const float rinv = rsqrtf(ss * (1.f / 64.f) + 1e-6f) * (isq ? (0.125f * 1.4426950408889634f) : 1.f);
    const int s1 = row;
    const int u = s2 * 128 + s1;
    u16* dst;
    if (isq) { int h = (nt - 4) * 2 + hd; dst = p.Q + ((long)(b * 8 + h) * 8192 + u) * 64; }
    else { dst = p.K + ((long)(b * 2 + hd) * 8192 + u) * 64; }
#pragma unroll 1
    for (int ax = 0; ax < 2; ax++) {
      const int pos = ax ? s2 : s1;
#pragma unroll 1
      for (int fq = 0; fq < 2; fq++) {
        float x0[8], x1[8], o0[8], o1[8];
#pragma unroll
        for (int e = 0; e < 8; e++) {
          int d0 = ax * 32 + fq * 8 + e, d1 = d0 + 16;
          x0[e] = sr[d0] * rinv * gn[d0];
          x1[e] = sr[d1] * rinv * gn[d1];
          float2 cs = p.ROPE[pos * 16 + fq * 8 + e];
          o0[e] = x0[e] * cs.x - x1[e] * cs.y;
          o1[e] = x1[e] * cs.x + x0[e] * cs.y;
        }
        uint4 pk;
        pk.x = pack2(o0[0], o0[1]); pk.y = pack2(o0[2], o0[3]); pk.z = pack2(o0[4], o0[5]); pk.w = pack2(o0[6], o0[7]);
        *(uint4*)(dst + ax * 32 + fq * 8) = pk;
        pk.x = pack2(o1[0], o1[1]); pk.y = pack2(o1[2], o1[3]); pk.z = pack2(o1[4], o1[5]); pk.w = pack2(o1[6], o1[7]);
        *(uint4*)(dst + ax * 32 + 16 + fq * 8) = pk;
      }
    }
  }
}
DI void inproj_epi_v(const P& p, const float* sC, int mt, const int tid) {
  const int b = mt >> 6, s2 = mt & 63;
#pragma unroll 1
  for (int unit = tid; unit < 2048; unit += NTHR) {
    int j = unit >> 4, ch = unit & 15;
    float4 a = *(const float4*)(sC + j * 132 + ch * 8), c = *(const float4*)(sC + j * 132 + ch * 8 + 4);
    uint4 o; o.x = pack2(a.x, a.y); o.y = pack2(a.z, a.w); o.z = pack2(c.x, c.y); o.w = pack2(c.z, c.w);
    *(uint4*)(p.VT + ((long)(b * 2) * 64 + j) * 8192 + s2 * 128 + ch * 8) = o;
  }
}
DI void inproj_epi_gates(const P& p, int l, const float* sC, int mt, int nt, const int tid) {
  const int c0 = (nt - 10) * 128;
  const float* bg = p.b_gate + l * 2048 + c0;
#pragma unroll 1
  for (int unit = tid; unit < 2048; unit += NTHR) {
    int row = unit >> 4, ch = unit & 15;
    float4 a = *(const float4*)(sC + row * 132 + ch * 8), c = *(const float4*)(sC + row * 132 + ch * 8 + 4);
    float4 ba = *(const float4*)(bg + ch * 8), bc = *(const float4*)(bg + ch * 8 + 4);
    float r0 = 1.f / (1.f + __expf(-(a.x + ba.x))), r1 = 1.f / (1.f + __expf(-(a.y + ba.y)));
    float r2 = 1.f / (1.f + __expf(-(a.z + ba.z))), r3 = 1.f / (1.f + __expf(-(a.w + ba.w)));
    float r4 = 1.f / (1.f + __expf(-(c.x + bc.x))), r5 = 1.f / (1.f + __expf(-(c.y + bc.y)));
    float r6 = 1.f / (1.f + __expf(-(c.z + bc.z))), r7 = 1.f / (1.f + __expf(-(c.w + bc.w)));
    uint4 o; o.x = pack2(r0, r1); o.y = pack2(r2, r3); o.z = pack2(r4, r5); o.w = pack2(r6, r7);
    *(uint4*)(p.GATES + ((long)mt * 128 + row) * 2048 + c0 + ch * 8) = o;
  }
}

DI void ph_inproj(const P& p, int l, char* smem, int bid, int nb, const Xcd xc) {
  const int tid = opaque_tid();
  float* sC = (float*)smem;
  const u16* W = p.WIN + (long)l * 3328 * 1024;
  XCD_TILE_LOOP(64, 12, mt2, nt2) {
    f32x16 acc[4][2];
    zero_acc<4>(acc);
    gemm_main<4>(p.XB + (long)mt2 * 256 * 1024, 1024, W + (long)nt2 * 256 * 1024, 1024, 1024, acc, smem, tid, 0);
#pragma unroll 1
    for (int q = 0; q < 4; q++) {
      const int mh = q >> 1, nh = q & 1, mt = mt2 * 2 + mh, nt = nt2 * 2 + nh;
      if (nt < 4) { stage_q_tr(acc, sC, tid, mh, nh); inproj_epi_fourier(p, sC, mt, nt, opaque_tid()); }
      else if (nt < 9) { stage_q(acc, sC, tid, mh, nh); inproj_epi_qk(p, l, sC, mt, nt, opaque_tid()); }
      else if (nt == 9) { stage_q_tr(acc, sC, tid, mh, nh); inproj_epi_v(p, sC, mt, opaque_tid()); }
      else { stage_q(acc, sC, tid, mh, nh); inproj_epi_gates(p, l, sC, mt, nt, opaque_tid()); }
      __syncthreads();
    }
  }
  for (int j_ = xc.slot; j_ < 32; j_ += xc.n) {
    const int mt4 = xc.id * 32 + j_;
    f32x16 acc1[1][2];
    zero_acc<1>(acc1);
    gemm_main<1>(p.XB + (long)mt4 * 64 * 1024, 1024, W + (long)12 * 256 * 1024, 1024, 1024, acc1, smem, tid, 0);
#pragma unroll 1
    for (int nh = 0; nh < 2; nh++) {
      stage_h1(acc1, sC, tid, nh);
      const int c0 = (24 + nh - 10) * 128;
      const float* bg = p.b_gate + l * 2048 + c0;
#pragma unroll 1
      for (int unit = opaque_tid(); unit < 1024; unit += NTHR) {
        int row = unit >> 4, ch = unit & 15;
        float4 a = *(const float4*)(sC + row * 132 + ch * 8), c = *(const float4*)(sC + row * 132 + ch * 8 + 4);
        float4 ba = *(const float4*)(bg + ch * 8), bc = *(const float4*)(bg + ch * 8 + 4);
        float r0 = 1.f / (1.f + __expf(-(a.x + ba.x))), r1 = 1.f / (1.f + __expf(-(a.y + ba.y)));
        float r2 = 1.f / (1.f + __expf(-(a.z + ba.z))), r3 = 1.f / (1.f + __expf(-(a.w + ba.w)));
        float r4 = 1.f / (1.f + __expf(-(c.x + bc.x))), r5 = 1.f / (1.f + __expf(-(c.y + bc.y)));
        float r6 = 1.f / (1.f + __expf(-(c.z + bc.z))), r7 = 1.f / (1.f + __expf(-(c.w + bc.w)));
        uint4 o; o.x = pack2(r0, r1); o.y = pack2(r2, r3); o.z = pack2(r4, r5); o.w = pack2(r6, r7);
        *(uint4*)(p.GATES + ((long)mt4 * 64 + row) * 2048 + c0 + ch * 8) = o;
      }
      __syncthreads();
    }
  }
}

DI void ph_fftA(const P& p, char* smem, int bid, int nb) {
  const int tid = opaque_tid();
  float* sC = (float*)smem;
  for (int t2 = bid; t2 < 130; t2 += nb) {
    f32x16 acc[4][2];
    zero_acc<4>(acc);
    gemm_main<4>(p.D256, 256, p.ZT + (long)t2 * 256 * 256, 256, 256, acc, smem, tid, t2);
#pragma unroll 1
    for (int q = 0; q < 4; q++) {
      const int mh = q >> 1, nh = q & 1, ntile = t2 * 2 + nh;
      stage_q(acc, sC, tid, mh, nh);
      if (tid < 256) {
        const int k1l = tid & 63, ch = (tid >> 6) & 1, po = tid >> 7;
        const int k1 = mh * 64 + k1l;
        const int qd = ntile * 2 + ch, bg = qd / 65, cp = qd % 65;
        u16* dst = p.GP + (((long)bg * 128 + k1) * 65 + cp) * 128 + po * 64;
        const float2* tw = p.TW + k1 * 64;
#pragma unroll 2
        for (int i = 0; i < 8; i++) {
          float o[8];
#pragma unroll
          for (int e = 0; e < 8; e++) {
            int s2 = i * 8 + e;
            float gr = sC[k1l * 132 + ch * 64 + s2], gi = sC[(64 + k1l) * 132 + ch * 64 + s2];
            float2 cs = tw[s2];
            o[e] = po ? (gi * cs.x - gr * cs.y) : (gr * cs.x + gi * cs.y);
          }
          uint4 pk; pk.x = pack2(o[0], o[1]); pk.y = pack2(o[2], o[3]); pk.z = pack2(o[4], o[5]); pk.w = pack2(o[6], o[7]);
          *(uint4*)(dst + i * 8) = pk;
        }
      }
      __syncthreads();
    }
  }
}

DI void ph_fftC(const P& p, char* smem, int bid, int nb) {
  const int tid = opaque_tid();
  float* sC = (float*)smem;
  for (int t2 = bid; t2 < 260; t2 += nb) {
    f32x16 acc[1][2];
    zero_acc<1>(acc);
    gemm_main<1>(p.C64, 128, p.GP + (long)t2 * 256 * 128, 128, 128, acc, smem, tid, 0);
#pragma unroll 1
    for (int nh = 0; nh < 2; nh++) {
      stage_h1(acc, sC, tid, nh);
      const int tile = t2 * 2 + nh;
      const int nl = tid & 127, kh = tid >> 7;
      const int idx = tile * 128 + nl;
      const int cp = idx % 65, k1 = (idx / 65) & 127, bg = idx / (65 * 128);
      const int b = bg >> 2, g = bg & 3;
      const bool mir = (cp >= 1 && cp <= 63);
      for (int i = 0; i < 16; i++) {
        int k2 = kh * 16 + i;
        u16 v = f2bf(sC[k2 * 132 + nl]);
        int k = k1 + 128 * k2;
        long tp = (long)b * 8192 + (k & 63) * 128 + (k >> 6);
        p.Y[tp * 512 + g * 128 + cp] = v;
        if (mir) {
          int km = (8192 - k) & 8191;
          long tm = (long)b * 8192 + (km & 63) * 128 + (km >> 6);
          p.Y[tm * 512 + g * 128 + 128 - cp] = v;
        }
      }
      __syncthreads();
    }
  }
}

DI void attn_item(const P& p, int l, int item, char* smem, const int tid, const int rot, const bool late) {
  const int lane = tid & 63, wave = tid >> 6;
  const int hg = item & 3, qb = (item >> 2) & 31, kvh = (item >> 7) & 1, b = item >> 8;
  const int h = kvh * 4 + hg;
  const int ql = lane & 31, hf = lane >> 5;
  const u16* Qp = p.Q + ((long)(b * 8 + h) * 8192 + qb * 256 + wave * 64) * 64;
  const u16* Kp = p.K + (long)(b * 2 + kvh) * 8192 * 64;
  const u16* Vp = p.VT + (long)(b * 2 + kvh) * 64 * 8192;
  u16* sK = (u16*)smem;
  u16* sV = sK + 3 * 64 * 72;
  f32x16 o[2][2];
#pragma unroll
  for (int dt = 0; dt < 2; dt++)
#pragma unroll
    for (int qt = 0; qt < 2; qt++)
#pragma unroll
      for (int r = 0; r < 16; r++) o[dt][qt][r] = 0.f;
  f32x2 ls[2] = {f32x2{0.f, 0.f}, f32x2{0.f, 0.f}};
  const int lr = tid >> 3, lc = (tid & 7) * 8;
  u32x4 rk[2], rv[2];
  __syncthreads();
#pragma unroll
  for (int c = 0; c < 2; c++) {
    rk[c] = *(const u32x4*)((const char*)Kp + ((long)(rot & 127) * 8192 + c * 4096) + (unsigned)((lr * 64 + lc) * 2));
    rv[c] = *(const u32x4*)((const char*)Vp + ((long)(rot & 127) * 128 + (long)c * 32 * 8192 * 2) + (unsigned)((lr * 8192 + lc) * 2));
  }
#pragma unroll
  for (int c = 0; c < 2; c++) {
    *(u32x4*)(sK + (lr + 32 * c) * 72 + lc) = rk[c];
    *(u32x4*)(sV + (lr + 32 * c) * 72 + lc) = rv[c];
  }
  __syncthreads();
  __builtin_amdgcn_sched_barrier(0);
  bf16x8 qf[2][4];
  float bound[2];
  float kmax = fabsf(p.kng[l * 64 + lane]);
  { kmax = fmaxf(kmax, shx<32>(kmax)); kmax = fmaxf(kmax, shx<16>(kmax)); kmax = fmaxf(kmax, shx<8>(kmax)); kmax = fmaxf(kmax, shx<4>(kmax)); kmax = fmaxf(kmax, shx<2>(kmax)); kmax = fmaxf(kmax, shx<1>(kmax)); }
  kmax *= 8.f * 1.02f;
#pragma unroll
  for (int qt = 0; qt < 2; qt++) {
    float ssq = 0.f;
#pragma unroll
    for (int kd = 0; kd < 4; kd++) {
      qf[qt][kd] = *(const bf16x8*)((const char*)Qp + (long)((qt * 32 * 64 + kd * 16) * 2) + (unsigned)((ql * 64 + hf * 8) * 2));
#pragma unroll
      for (int j = 0; j < 8; j++) { float v = bf2f((u16)qf[qt][kd][j]); ssq += v * v; }
    }
    ssq += shx<32>(ssq);
    bound[qt] = sqrtf(ssq) * kmax;
    __builtin_amdgcn_sched_barrier(0);
  }
  const unsigned offK = (unsigned)((lr * 64 + lc) * 2), offV = (unsigned)((lr * 8192 + lc) * 2);
  const char* Kb = (const char*)Kp;
  const char* Vb = (const char*)Vp;
#define ATT_LOAD(ktile)                                                                                   \
  { const long tk_ = (long)(((ktile) + rot) & 127);                                                       \
    rk[0] = *(const u32x4*)(Kb + tk_ * 8192 + offK); rk[1] = *(const u32x4*)(Kb + (tk_ * 8192 + 4096) + offK);          \
    rv[0] = *(const u32x4*)(Vb + tk_ * 128 + offV);  rv[1] = *(const u32x4*)(Vb + (tk_ * 128 + 32 * 8192 * 2) + offV); }
#define ATT_STORE(buf3)                                                                                   \
  { u16* nK = sK + (buf3) * 64 * 72; u16* nV = sV + (buf3) * 64 * 72;                                     \
    _Pragma("unroll") for (int c = 0; c < 2; c++) {                                                       \
      *(u32x4*)(nK + (lr + 32 * c) * 72 + lc) = rk[c];                                                    \
      *(u32x4*)(nV + (lr + 32 * c) * 72 + lc) = rv[c];                                                    \
    } }
#define ATT_KS(ks)                                                                                        \
    {                                                                                                     \
      f32x16 st[2];                                                                                       \
      _Pragma("unroll") for (int qt = 0; qt < 2; qt++)                                                    \
        _Pragma("unroll") for (int r = 0; r < 16; r++) st[qt][r] = -bound[qt];                            \
      _Pragma("unroll") for (int kd = 0; kd < 4; kd++) {                                                  \
        bf16x8 kf = *(const bf16x8*)(cK + ((ks) * 32 + ql) * 72 + kd * 16 + hf * 8);                      \
        _Pragma("unroll") for (int qt = 0; qt < 2; qt++) st[qt] = MFMA(kf, qf[qt][kd], st[qt]);           \
      }                                                                                                   \
      _Pragma("unroll") for (int qt = 0; qt < 2; qt++)                                                    \
        _Pragma("unroll") for (int r = 0; r < 16; r += 2) {                                               \
          float e0 = __builtin_amdgcn_exp2f(st[qt][r]), e1 = __builtin_amdgcn_exp2f(st[qt][r + 1]);      \
          st[qt][r] = e0; st[qt][r + 1] = e1;                                                             \
          ls[qt] += f32x2{e0, e1};                                                                        \
        }                                                                                                 \
      _Pragma("unroll") for (int s = 0; s < 2; s++) {                                                     \
        bf16x8 pf[2];                                                                                     \
        _Pragma("unroll") for (int qt = 0; qt < 2; qt++)                                                  \
          _Pragma("unroll") for (int j = 0; j < 8; j++) pf[qt][j] = (short)f2bf(st[qt][8 * s + j]);       \
        _Pragma("unroll") for (int dt = 0; dt < 2; dt++) {                                                \
          const u16* vp = cV + (dt * 32 + ql) * 72 + (ks) * 32 + 16 * s + 4 * hf;                         \
          s16x4 lo = *(const s16x4*)vp, hi = *(const s16x4*)(vp + 8);                                     \
          bf16x8 vf = __builtin_shufflevector(lo, hi, 0, 1, 2, 3, 4, 5, 6, 7);                            \
          _Pragma("unroll") for (int qt = 0; qt < 2; qt++) o[dt][qt] = MFMA(vf, pf[qt], o[dt][qt]);       \
        }                                                                                                 \
      }                                                                                                   \
      __builtin_amdgcn_sched_barrier(0);                                                                  \
    }
  if (late) { ATT_LOAD(1) }
  int cur3 = 0;
  for (int kt = 0; kt < 128; kt++) {
    const int nxt3 = (cur3 == 2) ? 0 : cur3 + 1;
    const u16* cK = sK + cur3 * 64 * 72;
    const u16* cV = sV + cur3 * 64 * 72;
    if (!late) { if (kt + 1 < 128) { ATT_LOAD(kt + 1) } }
    ATT_KS(0)
    if (late) {
      if (kt + 1 < 128) { ATT_STORE(nxt3) }
      __syncthreads();
      if (kt + 2 < 128) { ATT_LOAD(kt + 2) }
    }
    ATT_KS(1)
    if (!late) {
      if (kt + 1 < 128) { ATT_STORE(nxt3) }
      __syncthreads();
    }
    cur3 = nxt3;
  }
  __syncthreads();
#undef ATT_LOAD
#undef ATT_STORE
#undef ATT_KS
  const int te_ = opaque_vtid();
  const int lane_e = te_ & 63, wave_e = te_ >> 6, ql_e = lane_e & 31, hf_e = lane_e >> 5;
  u16* sO = (u16*)smem + wave_e * 64 * 72;
#pragma unroll
  for (int qt = 0; qt < 2; qt++) {
    float lt = ls[qt].x + ls[qt].y;
    lt += shx<32>(lt);
    const float inv = 1.f / lt;
#pragma unroll
    for (int dt = 0; dt < 2; dt++)
#pragma unroll
      for (int rq = 0; rq < 4; rq++) {
        int d = dt * 32 + 8 * rq + 4 * hf_e;
        uint2 pk; pk.x = pack2(o[dt][qt][rq * 4] * inv, o[dt][qt][rq * 4 + 1] * inv); pk.y = pack2(o[dt][qt][rq * 4 + 2] * inv, o[dt][qt][rq * 4 + 3] * inv);
        *(uint2*)(sO + (qt * 32 + ql_e) * 72 + d) = pk;
      }
  }
  __syncthreads();
  u16* dst = p.AO + ((long)b * 8192 + qb * 256 + wave_e * 64) * 512 + h * 64;
#pragma unroll 2
  for (int i = 0; i < 8; i++) {
    int unit = lane_e + 64 * i, q = unit >> 3, ch = unit & 7;
    *(uint4*)(dst + (long)q * 512 + ch * 8) = *(const uint4*)(sO + q * 72 + ch * 8);
  }
  __syncthreads();
}

DI void ph_attn(const P& p, int l, char* smem, const Xcd xc, const int vb) {
  const int tid = opaque_vtid();
  for (int base = xc.slot * 2; base < 64; base += xc.n * 2) {
    const int sl = base + vb;
    attn_item(p, l, ((xc.id >> 1) << 7) | ((xc.id & 1) << 6) | sl, smem, tid, sl * 2, vb != 0);
  }
}

DI void ph_branch(const P& p, int l, char* smem, int bid, int nb, const Xcd xc) {
  const int tid = opaque_tid();
  float* sC = (float*)smem;
  XCD_TILE_LOOP(64, 4, mt2, nt2) {
    f32x16 a1[4][2];
    zero_acc<4>(a1);
    gemm_main<4>(p.Y + (long)mt2 * 256 * 512, 512, p.WBF + ((long)l * 1024 + nt2 * 256) * 512, 512, 512, a1, smem, tid, 0);
#pragma unroll 1
    for (int q = 0; q < 4; q++) {
      const int mh = q >> 1, nh = q & 1, mt = mt2 * 2 + mh, nt = nt2 * 2 + nh;
      stage_q(a1, sC, tid, mh, nh);
#pragma unroll 1
      for (int unit = opaque_tid(); unit < 2048; unit += NTHR) {
        int row = unit >> 4, ch = unit & 15;
        const u16* gp = p.GATES + ((long)mt * 128 + row) * 2048 + nt * 128 + ch * 8;
        uint4 gf = *(const uint4*)gp, ga = *(const uint4*)(gp + 1024);
        float* sp = sC + row * 132 + ch * 8;
        float4 a = *(const float4*)sp, c = *(const float4*)(sp + 4);
        a.x *= bflo(gf.x) / fmaxf(bflo(ga.x), 1e-20f); a.y *= bfhi(gf.x) / fmaxf(bfhi(ga.x), 1e-20f);
        a.z *= bflo(gf.y) / fmaxf(bflo(ga.y), 1e-20f); a.w *= bfhi(gf.y) / fmaxf(bfhi(ga.y), 1e-20f);
        c.x *= bflo(gf.z) / fmaxf(bflo(ga.z), 1e-20f); c.y *= bfhi(gf.z) / fmaxf(bfhi(ga.z), 1e-20f);
        c.z *= bflo(gf.w) / fmaxf(bflo(ga.w), 1e-20f); c.w *= bfhi(gf.w) / fmaxf(bfhi(ga.w), 1e-20f);
        *(float4*)sp = a; *(float4*)(sp + 4) = c;
      }
      __syncthreads();
      unstage_q(a1, sC, tid, mh, nh);
    }
    gemm_main<4>(p.AO + (long)mt2 * 256 * 512, 512, p.WBA + ((long)l * 1024 + nt2 * 256) * 512, 512, 512, a1, smem, tid, 0);
#pragma unroll 1
    for (int q = 0; q < 4; q++) {
      const int mh = q >> 1, nh = q & 1, mt = mt2 * 2 + mh, nt = nt2 * 2 + nh;
      stage_q(a1, sC, tid, mh, nh);
#pragma unroll 1
      for (int unit = opaque_tid(); unit < 2048; unit += NTHR) {
        int row = unit >> 4, ch = unit & 15;
        uint4 ga = *(const uint4*)(p.GATES + ((long)mt * 128 + row) * 2048 + 1024 + nt * 128 + ch * 8);
        float4 a = *(const float4*)(sC + row * 132 + ch * 8), c = *(const float4*)(sC + row * 132 + ch * 8 + 4);
        uint4 o;
        o.x = pack2(a.x * fmaxf(bflo(ga.x), 1e-20f), a.y * fmaxf(bfhi(ga.x), 1e-20f));
        o.y = pack2(a.z * fmaxf(bflo(ga.y), 1e-20f), a.w * fmaxf(bfhi(ga.y), 1e-20f));
        o.z = pack2(c.x * fmaxf(bflo(ga.z), 1e-20f), c.y * fmaxf(bfhi(ga.z), 1e-20f));
        o.w = pack2(c.z * fmaxf(bflo(ga.w), 1e-20f), c.w * fmaxf(bfhi(ga.w), 1e-20f));
        *(uint4*)(p.MIXED + ((long)mt * 128 + row) * 1024 + nt * 128 + ch * 8) = o;
      }
      __syncthreads();
    }
  }
}

DI void ph_outproj(const P& p, int l, char* smem, int bid, int nb, const Xcd xc) {
  const int tid = opaque_tid();
  float* sC = (float*)smem;
  XCD_TILE_LOOP(64, 4, mt2, nt2) {
    f32x16 acc[4][2];
    zero_acc<4>(acc);
    gemm_main<4>(p.MIXED + (long)mt2 * 256 * 1024, 1024, p.WOUT + ((long)l * 1024 + nt2 * 256) * 1024, 1024, 1024, acc, smem, tid, 0);
#pragma unroll 1
    for (int q = 0; q < 4; q++) {
      const int mh = q >> 1, nh = q & 1, mt = mt2 * 2 + mh, nt = nt2 * 2 + nh;
      stage_q(acc, sC, tid, mh, nh);
#pragma unroll 1
      for (int unit = opaque_tid(); unit < 2048; unit += NTHR) {
        int row = unit >> 4, ch = unit & 15;
        long gi = ((long)mt * 128 + row) * 1024 + nt * 128 + ch * 8;
        float4 a = *(const float4*)(sC + row * 132 + ch * 8), c = *(const float4*)(sC + row * 132 + ch * 8 + 4);
        float4 xa = *(const float4*)(p.XS + gi), xc4 = *(const float4*)(p.XS + gi + 4);
        a.x += ALPHA * xa.x; a.y += ALPHA * xa.y; a.z += ALPHA * xa.z; a.w += ALPHA * xa.w;
        c.x += ALPHA * xc4.x; c.y += ALPHA * xc4.y; c.z += ALPHA * xc4.z; c.w += ALPHA * xc4.w;
        *(float4*)(p.out + gi) = a; *(float4*)(p.out + gi + 4) = c;
      }
      __syncthreads();
    }
  }
}

DI void ph_ln1(const P& p, int l, int bid, int nb) {
  const int tid = opaque_vtid(), lane = tid & 63, wave = tid >> 6;
  for (int row = bid * 4 + wave; row < T; row += nb * 4) {
    const float* src = p.out + (long)row * 1024;
    float v[16];
#pragma unroll
    for (int c = 0; c < 4; c++) { float4 t = *(const float4*)(src + (lane + 64 * c) * 4); v[c * 4] = t.x; v[c * 4 + 1] = t.y; v[c * 4 + 2] = t.z; v[c * 4 + 3] = t.w; }
    ln16_write(v, p.ln1g + l * 1024, p.ln1b + l * 1024, p.XS + (long)row * 1024, p.XB + (long)row * 1024, lane);
  }
}

DI void ph_peerq(const P& p, int l, char* smem, int bid, int nb, const Xcd xc) {
  const int tid = opaque_tid();
  float* sC = (float*)smem;
  XCD_TILE_LOOP(64, 8, mt2, nt2) {
    f32x16 acc[4][2];
    zero_acc<4>(acc);
    gemm_main<4>(p.XB + (long)mt2 * 256 * 1024, 1024, p.WQ + ((long)l * 2048 + nt2 * 256) * 1024, 1024, 1024, acc, smem, tid, 0);
#pragma unroll 1
    for (int q = 0; q < 4; q++) {
      const int mh = q >> 1, nh = q & 1, mt = mt2 * 2 + mh, nt = nt2 * 2 + nh;
      stage_q(acc, sC, tid, mh, nh);
#pragma unroll 1
      for (int unit = opaque_tid(); unit < 2048; unit += NTHR) {
        int row = unit >> 4, ch = unit & 15;
        float4 a = *(const float4*)(sC + row * 132 + ch * 8), c = *(const float4*)(sC + row * 132 + ch * 8 + 4);
        uint4 o; o.x = pack2(a.x, a.y); o.y = pack2(a.z, a.w); o.z = pack2(c.x, c.y); o.w = pack2(c.z, c.w);
        *(uint4*)(p.QP + ((long)mt * 128 + row) * 2048 + nt * 128 + ch * 8) = o;
      }
      __syncthreads();
    }
  }
}

DI int okey(float v) { int b = __float_as_int(v); return b ^ ((b >> 31) & 0x7fffffff); }
DI float okey_val(int k) { return __int_as_float(k ^ ((k >> 31) & 0x7fffffff)); }
DI int med3i(int a, int b, int c) { int r; asm("v_med3_i32 %0, %1, %2, %3" : "=v"(r) : "v"(a), "v"(b), "v"(c)); return r; }
DI void ins16(int (&L)[16], int x) {
#pragma unroll
  for (int i = 15; i > 0; i--) L[i] = med3i(L[i - 1], L[i], x);
  L[0] = max(L[0], x);
}

DI void peer_finish_token(const P& p, int l, bool last, const long tok, f32x2 (&acc2)[8], float csum, const int lane) {
      float acc[16];
#pragma unroll
      for (int i = 0; i < 8; i++) { acc[2 * i] = acc2[i].x; acc[2 * i + 1] = acc2[i].y; }
      csum *= 128.f;
      const float* xs = p.XS + tok * 1024 + lane * 16;
      float y[16];
#pragma unroll
      for (int c = 0; c < 4; c++) {
        float4 a = *(const float4*)(xs + c * 4);
        y[c * 4 + 0] = ALPHA * a.x + acc[c * 4 + 0] - csum; y[c * 4 + 1] = ALPHA * a.y + acc[c * 4 + 1] - csum;
        y[c * 4 + 2] = ALPHA * a.z + acc[c * 4 + 2] - csum; y[c * 4 + 3] = ALPHA * a.w + acc[c * 4 + 3] - csum;
      }
      float s = 0.f;
#pragma unroll
      for (int i = 0; i < 16; i++) s += y[i];
      float mu = wave_sum(s) * (1.f / 1024.f);
      float q = 0.f;
#pragma unroll
      for (int i = 0; i < 16; i++) { float dd = y[i] - mu; q += dd * dd; }
      float rstd = rsqrtf(wave_sum(q) * (1.f / 1024.f) + 1e-5f);
      const float* g = p.ln2g + l * 1024;
      const float* bt = p.ln2b + l * 1024;
      float* dstf;
      if (last) {
        int b = (int)(tok >> 13), u = (int)(tok & 8191);
        int sact = (u & 127) * 64 + (u >> 7);
        dstf = p.out + ((long)b * 8192 + sact) * 1024;
      } else dstf = p.XS + tok * 1024;
      {
        const int e0 = lane * 16;
        float o[16];
#pragma unroll
        for (int c = 0; c < 4; c++) {
          float4 g0 = *(const float4*)(g + e0 + c * 4), b0 = *(const float4*)(bt + e0 + c * 4);
          o[c * 4 + 0] = (y[c * 4 + 0] - mu) * rstd * g0.x + b0.x; o[c * 4 + 1] = (y[c * 4 + 1] - mu) * rstd * g0.y + b0.y;
          o[c * 4 + 2] = (y[c * 4 + 2] - mu) * rstd * g0.z + b0.z; o[c * 4 + 3] = (y[c * 4 + 3] - mu) * rstd * g0.w + b0.w;
          *(float4*)(dstf + e0 + c * 4) = make_float4(o[c * 4], o[c * 4 + 1], o[c * 4 + 2], o[c * 4 + 3]);
        }
        if (!last) {
          uint4 pk; pk.x = pack2(o[0], o[1]); pk.y = pack2(o[2], o[3]); pk.z = pack2(o[4], o[5]); pk.w = pack2(o[6], o[7]);
          *(uint4*)(p.XB + tok * 1024 + e0) = pk;
          pk.x = pack2(o[8], o[9]); pk.y = pack2(o[10], o[11]); pk.z = pack2(o[12], o[13]); pk.w = pack2(o[14], o[15]);
          *(uint4*)(p.XB + tok * 1024 + e0 + 8) = pk;
        }
      }
}

DI void ph_peer(const P& p, int l, char* smem, int bid, int nb, bool last) {
  const int tid = opaque_vtid(), lane = tid & 63, wave = tid >> 6;
  const int tl = lane & 31, hf = lane >> 5;
  int* sel_e = (int*)smem;
  float* sel_w = (float*)(smem + 16384);
  unsigned char* sidx = (unsigned char*)(smem + 32768);
  float* scoef = (float*)(smem + 32768 + 4096);
  const u16* SKl = p.SK + (long)l * 8 * 2 * 128 * 128;
  const unsigned char* Ul = p.U8 + (long)l * 16384 * 1024;
  const unsigned char* Vl = p.V8 + (long)l * 16384 * 1024;
  const float* SUl = p.SU + l * 16384;
  const float* SVl = p.SV + l * 16384;
  for (int tk = bid; tk < T / 32; tk += nb) {
    const int t0 = tk * 32;
    const int tidr_ = opaque_vtid();
    const int lane = tidr_ & 63, wave = tidr_ >> 6, tl = lane & 31, hf = lane >> 5;
    __syncthreads();
    for (int hi = 0; hi < 2; hi++) {
      const int hh = wave + 4 * hi;
      int L1[16], L2[16];
#pragma unroll
      for (int half = 0; half < 2; half++) {
        f32x16 acc[4];
#pragma unroll
        for (int mt = 0; mt < 4; mt++)
#pragma unroll
          for (int r = 0; r < 16; r++) acc[mt][r] = 0.f;
        const u16* qrow = p.QP + (long)(t0 + tl) * 2048 + hh * 256 + half * 128 + hf * 8;
        const u16* krow = SKl + ((long)(hh * 2 + half) * 128 + tl) * 128 + hf * 8;
#pragma unroll
        for (int kd = 0; kd < 8; kd++) {
          bf16x8 bq = *(const bf16x8*)(qrow + kd * 16);
#pragma unroll
          for (int mt = 0; mt < 4; mt++) {
            bf16x8 ak = *(const bf16x8*)(krow + (long)mt * 32 * 128 + kd * 16);
            acc[mt] = MFMA(ak, bq, acc[mt]);
          }
          if (kd == 3) __builtin_amdgcn_sched_barrier(0);
        }
        int L[16];
#pragma unroll
        for (int i = 0; i < 16; i++) L[i] = (int)0x80000000;
#pragma unroll
        for (int mt = 0; mt < 4; mt++)
#pragma unroll
          for (int r = 0; r < 16; r++) {
            int key = mt * 32 + 8 * (r >> 2) + 4 * hf + (r & 3);
            int k = (okey(acc[mt][r]) & ~0x7f) | (127 - key);
            ins16(L, k);
          }
        int S[16];
#pragma unroll
        for (int i = 0; i < 16; i++) S[i] = L[i];
#pragma unroll
        for (int i = 0; i < 16; i++) { int pv = shxi<32>(S[i]); ins16(L, pv); }
        if (half == 0) {
#pragma unroll
          for (int i = 0; i < 16; i++) L1[i] = L[i];
        } else {
#pragma unroll
          for (int i = 0; i < 16; i++) L2[i] = L[i];
        }
      }
      float v1[16], v2[16];
#pragma unroll
      for (int i = 0; i < 16; i++) { v1[i] = okey_val(L1[i] & ~0x7f); v2[i] = okey_val(L2[i] & ~0x7f); }
      unsigned char* myidx = sidx + (wave * 32 + tl) * 32;
      if (hf == 0) {
#pragma unroll
        for (int i = 0; i < 16; i++) { myidx[i] = (unsigned char)(127 - (L1[i] & 0x7f)); myidx[16 + i] = (unsigned char)(127 - (L2[i] & 0x7f)); }
      }
      int C[16];
#pragma unroll
      for (int i = 0; i < 16; i++) C[i] = (int)0x80000000;
#pragma unroll
      for (int i = 0; i < 16; i++)
#pragma unroll
        for (int j = 0; j < 16; j++)
          if ((i + 1) * (j + 1) <= 16) {
            int k = (okey(v1[i] + v2[j]) & ~0xff) | (255 - (i * 16 + j));
            ins16(C, k);
          }
      float sv[16];
#pragma unroll
      for (int r = 0; r < 16; r++) sv[r] = okey_val(C[r] & ~0xff);
      float den = 0.f;
      {
        float top = sv[0];
#pragma unroll
        for (int r = 0; r < 16; r++) { sv[r] = __expf(sv[r] - top); den += sv[r]; }
      }
      float rden = 1.f / den;
#pragma unroll
      for (int r = 0; r < 16; r++) {
        if ((r >> 3) == hf) {
          int pos = 255 - (C[r] & 0xff);
          int i1 = myidx[pos >> 4], i2 = myidx[16 + (pos & 15)];
          sel_e[tl * 128 + hh * 16 + r] = i1 * 128 + i2;
          sel_w[tl * 128 + hh * 16 + r] = sv[r] * rden;
        }
      }
    }
    __syncthreads();
    int* nlo_tab = (int*)sidx;
    for (int tt = wave; tt < 32; tt += 4) {
      const int e0_ = sel_e[tt * 128 + lane], e1_ = sel_e[tt * 128 + lane + 64];
      const float w0_ = sel_w[tt * 128 + lane], w1_ = sel_w[tt * 128 + lane + 64];
      const bool lo0 = e0_ < 8192, lo1 = e1_ < 8192;
      const unsigned long long m0 = __ballot(lo0), m1 = __ballot(lo1);
      const unsigned long long lt = (1ull << lane) - 1ull;
      const int c0 = __popcll(m0), c1 = __popcll(m1), nlo = c0 + c1;
      const int p0 = lo0 ? __popcll(m0 & lt) : nlo + __popcll(~m0 & lt);
      const int p1 = lo1 ? c0 + __popcll(m1 & lt) : nlo + (64 - c0) + __popcll(~m1 & lt);
      __builtin_amdgcn_wave_barrier();
      sel_e[tt * 128 + p0] = e0_; sel_e[tt * 128 + p1] = e1_;
      sel_w[tt * 128 + p0] = w0_; sel_w[tt * 128 + p1] = w1_;
      if (lane == 0) nlo_tab[tt] = nlo;
    }
    __builtin_amdgcn_wave_barrier();
    {
    const int tidg_ = opaque_vtid();
    const int lane = tidg_ & 63, wave = tidg_ >> 6;
    const int sub = lane & 15, grp = lane >> 4;
#pragma unroll 1
    for (int upass = 0; upass < 2; upass++)
    for (int tt = wave; tt < 32; tt += 4) {
      const long tok = t0 + tt;
      const int ssp = ((nlo_tab[tt] + 8) >> 4) << 1;
      const int s_beg = upass ? ssp : 0, s_end = upass ? 16 : ssp;
      f32x2 xf[32];
      float sx = 0.f;
#pragma unroll
      for (int c = 0; c < 4; c++) {
#pragma unroll
        for (int h2 = 0; h2 < 2; h2++) {
          uint4 xr = *(const uint4*)(p.XB + tok * 1024 + (sub + 16 * c) * 16 + h2 * 8);
          f32x2* xp = xf + c * 8 + h2 * 4;
          xp[0] = f32x2{bflo(xr.x), bfhi(xr.x)}; xp[1] = f32x2{bflo(xr.y), bfhi(xr.y)};
          xp[2] = f32x2{bflo(xr.z), bfhi(xr.z)}; xp[3] = f32x2{bflo(xr.w), bfhi(xr.w)};
        }
      }
#pragma unroll
      for (int i = 0; i < 32; i++) sx += xf[i].x + xf[i].y;
      sx *= 128.f;
      float dk0 = 0.f, dk1 = 0.f;
      u32x4 bufA[8], bufB[8];
#define ISSUE_U(buf, st)                                                                 \
      _Pragma("unroll") for (int j = 0; j < 2; j++) {                                    \
        const int eidx_ = sel_e[tt * 128 + ((st) * 2 + j) * 4 + grp];                    \
        const unsigned char* ur_ = Ul + (long)eidx_ * 1024 + sub * 16;                   \
        _Pragma("unroll") for (int c = 0; c < 4; c++) buf[j * 4 + c] = *(const u32x4*)(ur_ + c * 256); \
      }
#define COMPUTE_U(buf, st)                                                               \
      _Pragma("unroll") for (int j = 0; j < 2; j++) {                                    \
        f32x2 d2 = f32x2{-sx, 0.f};                                                      \
        _Pragma("unroll") for (int c = 0; c < 4; c++)                                    \
          _Pragma("unroll") for (int w = 0; w < 4; w++) {                                \
            const unsigned q = buf[j * 4 + c][w];                                        \
            d2 += f32x2{(float)(q & 0xffu), (float)((q >> 8) & 0xffu)} * xf[c * 8 + w * 2];      \
            d2 += f32x2{(float)((q >> 16) & 0xffu), (float)(q >> 24)} * xf[c * 8 + w * 2 + 1];   \
          }                                                                              \
        float d = d2.x + d2.y;                                                           \
        d += shx<1>(d); d += shx<2>(d); d += shx<4>(d); d += shx<8>(d); \
        const int it_ = (st) * 2 + j;                                                    \
        if (sub == (it_ & 15)) { if (it_ < 16) dk0 = d; else dk1 = d; }                  \
        __builtin_amdgcn_sched_barrier(0);                                               \
      }
      if (s_beg < s_end) { ISSUE_U(bufA, s_beg) }
      for (int st = s_beg; st < s_end; st += 2) {
        ISSUE_U(bufB, st + 1)
        COMPUTE_U(bufA, st)
        if (st + 2 < s_end) { ISSUE_U(bufA, st + 2) }
        COMPUTE_U(bufB, st + 1)
      }
      {
        const int e0 = sub * 4 + grp, e1 = (16 + sub) * 4 + grp;
        const bool in0 = (sub >= 2 * s_beg) && (sub < 2 * s_end), in1 = (16 + sub >= 2 * s_beg) && (16 + sub < 2 * s_end);
        const int x0 = sel_e[tt * 128 + e0], x1 = sel_e[tt * 128 + e1];
        float d0 = dk0 * SUl[x0], d1 = dk1 * SUl[x1];
        float a0 = 0.5f * d0 * (1.f + erff(d0 * 0.7071067811865476f));
        float a1 = 0.5f * d1 * (1.f + erff(d1 * 0.7071067811865476f));
        if (in0) sel_w[tt * 128 + e0] = a0 * sel_w[tt * 128 + e0] * SVl[x0];
        if (in1) sel_w[tt * 128 + e1] = a1 * sel_w[tt * 128 + e1] * SVl[x1];
      }
    }
#pragma unroll 1
    for (int hsel = 0; hsel < 2; hsel++) {
      f32x2 accT[4][8];
      float csumT[4];
#pragma unroll
      for (int ti = 0; ti < 4; ti++) {
        csumT[ti] = 0.f;
#pragma unroll
        for (int i = 0; i < 8; i++) accT[ti][i] = f32x2{0.f, 0.f};
      }
#define ISSUE_V(buf, tt_, st)                                                            \
      _Pragma("unroll") for (int j = 0; j < 8; j++) {                                    \
        const int eidx_ = __builtin_amdgcn_readfirstlane(sel_e[(tt_) * 128 + (st) * 8 + j]); \
        buf[j] = *(const u32x4*)(Vl + (long)eidx_ * 1024 + (unsigned)(lane * 16));       \
      }
#define COMPUTE_V(buf, ti, tt_, st)                                                      \
      _Pragma("unroll") for (int j = 0; j < 8; j++) {                                    \
        const float c_ = sel_w[(tt_) * 128 + (st) * 8 + j];                              \
        csumT[ti] += c_;                                                                 \
        const f32x2 c2 = f32x2{c_, c_};                                                  \
        _Pragma("unroll") for (int w = 0; w < 4; w++) {                                  \
          const unsigned q = buf[j][w];                                                  \
          accT[ti][w * 2] += c2 * f32x2{(float)(q & 0xffu), (float)((q >> 8) & 0xffu)};  \
          accT[ti][w * 2 + 1] += c2 * f32x2{(float)((q >> 16) & 0xffu), (float)(q >> 24)}; \
        }                                                                                \
        if (j & 1) __builtin_amdgcn_sched_barrier(0);                                    \
      }
#pragma unroll 1
      for (int vpass = 0; vpass < 2; vpass++) {
#pragma unroll
        for (int ti = 0; ti < 4; ti++) {
          const int tt = wave + 4 * (hsel * 4 + ti);
          const int ssp = ((nlo_tab[tt] + 8) >> 4) << 1;
          const int c_beg = vpass ? ssp : 0, c_end = vpass ? 16 : ssp;
          u32x4 bufA[8], bufB[8];
          if (c_beg < c_end) { ISSUE_V(bufA, tt, c_beg) }
#pragma unroll 1
          for (int st = c_beg; st < c_end; st += 2) {
            ISSUE_V(bufB, tt, st + 1)
            COMPUTE_V(bufA, ti, tt, st)
            if (st + 2 < c_end) { ISSUE_V(bufA, tt, st + 2) }
            COMPUTE_V(bufB, ti, tt, st + 1)
          }
        }
      }
      peer_finish_token(p, l, last, t0 + wave + 4 * (hsel * 4 + 0), accT[0], csumT[0], lane);
      peer_finish_token(p, l, last, t0 + wave + 4 * (hsel * 4 + 1), accT[1], csumT[1], lane);
      peer_finish_token(p, l, last, t0 + wave + 4 * (hsel * 4 + 2), accT[2], csumT[2], lane);
      peer_finish_token(p, l, last, t0 + wave + 4 * (hsel * 4 + 3), accT[3], csumT[3], lane);
    }
    }
  }
}


#define XB_TMO      128
#define XB_XCNT(j)  (256  + 64 * (j))
#define XB_XSUB(j)  (1280 + 64 * (j))
#define XB_XGEN(j)  (2304 + 64 * (j))
#define XB_TOP      3328
#define XB_TOPGEN   3392
#define XB_CENSUS   3456
#define XCD_BAR_WORDS 3472
#define XB_SPIN_CAP (1u << 22)
DI unsigned xb_ld(unsigned* p) { return __hip_atomic_load(p, __ATOMIC_RELAXED, __HIP_MEMORY_SCOPE_AGENT); }
DI unsigned xb_add(unsigned* p, unsigned v) { return __hip_atomic_fetch_add(p, v, __ATOMIC_RELAXED, __HIP_MEMORY_SCOPE_AGENT); }
DI unsigned xb_xcc_id() { return (unsigned)__builtin_amdgcn_s_getreg((3 << 11) | 20) & 0xFu; }
#define XB_SPIN(cond, bar) do { unsigned _sp = 0; while (cond) { __builtin_amdgcn_s_sleep(1); \
    if ((++_sp & 255u) == 0u) { if (xb_ld(&(bar)[XB_TMO])) break; if (_sp > XB_SPIN_CAP) { atomicAdd(&(bar)[XB_TMO], 1u); break; } } } } while (0)
struct XcdBarrier { unsigned* bar; unsigned x; volatile LAS unsigned* st; };
DI volatile LAS unsigned* xb_state() { __shared__ uint4 xb_words_; return (volatile LAS unsigned*)&xb_words_; }
DI XcdBarrier xcd_barrier_post(unsigned* bar, volatile LAS unsigned* st) {
  XcdBarrier b; b.bar = bar; b.x = xb_xcc_id(); b.st = st;
  if (threadIdx.x == 0) (void)xb_add(&bar[XB_XCNT(b.x)], 1u);
  return b;
}
DI void xcd_barrier_complete(unsigned* bar, unsigned x, unsigned& nloc, unsigned& nx) {
  const unsigned G = gridDim.x;
  unsigned sum, cnt, mine, sp = 0u;
  for (;;) {
    sum = 0u; cnt = 0u; mine = 0u;
#pragma unroll
    for (unsigned j = 0; j < 16; ++j) { const unsigned c = xb_ld(&bar[XB_XCNT(j)]); sum += c; cnt += (c > 0u) ? 1u : 0u; mine = (j == x) ? c : mine; }
    if (sum == G) break;
    __builtin_amdgcn_s_sleep(1);
    if ((++sp & 255u) == 0u) { if (xb_ld(&bar[XB_TMO])) break; if (sp > XB_SPIN_CAP) { atomicAdd(&bar[XB_TMO], 1u); break; } }
  }
  nloc = mine > 0u ? mine : 1u; nx = cnt > 0u ? cnt : 1u;
}
DI void xcd_barrier(unsigned* bar_, volatile LAS unsigned* st_) {
  XcdBarrier b; b.bar = bar_; b.st = st_; b.x = xb_xcc_id();
  asm volatile("s_waitcnt vmcnt(0)" ::: "memory");
  __syncthreads();
  if (opaque_tid() == 0) {
    unsigned* bar = b.bar;
    __builtin_amdgcn_s_waitcnt(0);
    unsigned nloc = b.st[0], nx = b.st[1];
    if (nloc == 0u) { xcd_barrier_complete(bar, b.x, nloc, nx); b.st[0] = nloc; b.st[1] = nx; }
    const unsigned old = xb_add(&bar[XB_XSUB(b.x)], 1u);
    const unsigned gen = old / nloc;
    if (old + 1u == (gen + 1u) * nloc) {
      __builtin_amdgcn_fence(__ATOMIC_RELEASE, "agent");
      asm volatile("s_waitcnt vmcnt(0)" ::: "memory");
      const unsigned og = xb_add(&bar[XB_TOP], 1u);
      const unsigned tg = og / nx;
      if (og + 1u == (tg + 1u) * nx) xb_add(&bar[XB_TOPGEN], 1u);
      else XB_SPIN(xb_ld(&bar[XB_TOPGEN]) == tg, bar);
      __builtin_amdgcn_fence(__ATOMIC_ACQUIRE, "agent");
      xb_add(&bar[XB_XGEN(b.x)], 1u);
      asm volatile("s_waitcnt vmcnt(0)" ::: "memory");
    } else {
      XB_SPIN(xb_ld(&bar[XB_XGEN(b.x)]) == gen, bar);
      __builtin_amdgcn_fence(__ATOMIC_ACQUIRE, "agent");
      asm volatile("s_waitcnt vmcnt(0)" ::: "memory");
    }
  }
  __syncthreads();
}

#ifndef REP
#define REP -1
#endif
#define BAR() xcd_barrier(p.BAR, xb_state())
#define RUNPH(k, call) do { call; if (REP == (k)) { BAR(); call; } } while (0)
__global__ void __launch_bounds__(NTHR, 2) mega_kernel(P p) {
  extern __shared__ __attribute__((aligned(1024))) char smem[];
  __shared__ int xc_sh[2];
  const int bid = blockIdx.x, nb = gridDim.x;
  if (threadIdx.x == 0) { volatile LAS unsigned* st = xb_state(); st[0] = 0u; st[1] = 0u; st[2] = 0u; st[3] = 0u; }
  if ((threadIdx.x & 63) == 0) wmap()[hw_slot()] = (int)(threadIdx.x >> 6);
  __syncthreads();
  (void)xcd_barrier_post(p.BAR, xb_state());
  if (threadIdx.x == 0) { const unsigned x = xb_xcc_id() & 7u; xc_sh[0] = (int)x; xc_sh[1] = (int)xb_add(&p.BAR[XB_CENSUS + x], 1u); }
  __syncthreads();
  const int vb = __builtin_amdgcn_readfirstlane((int)threadIdx.x >> 8);
  const int vbid = bid * 2 + vb, vnb = nb * 2;
  char* vsmem = smem + vb * VSMEM;
  RUNPH(0, ph_prep(p, vsmem, vbid, vnb));
  BAR();
  Xcd xc;
  xc.id = __builtin_amdgcn_readfirstlane(xc_sh[0]); xc.slot = __builtin_amdgcn_readfirstlane(xc_sh[1]);
  xc.n = __builtin_amdgcn_readfirstlane((int)xb_ld(&p.BAR[XB_CENSUS + xc.id]));
#pragma unroll 1
  for (int l = 0; l < 2; l++) {
    RUNPH(1, ph_inproj(p, l, smem, bid, nb, xc));
    BAR();
    ph_fftA(p, smem, bid, nb);
    RUNPH(2, ph_attn(p, l, vsmem, xc, vb));
    BAR();
    RUNPH(3, ph_fftC(p, smem, bid, nb));
    BAR();
    RUNPH(4, ph_branch(p, l, smem, bid, nb, xc));
    BAR();
    RUNPH(5, ph_outproj(p, l, smem, bid, nb, xc));
    BAR();
    RUNPH(6, ph_ln1(p, l, vbid, vnb));
    BAR();
    RUNPH(7, ph_peerq(p, l, smem, bid, nb, xc));
    BAR();
    if (REP == 8) { ph_peer(p, l, vsmem, vbid, vnb, true); BAR(); }
    ph_peer(p, l, vsmem, vbid, vnb, l == 1);
    if (l == 0) BAR();
  }
}

extern "C" void kernel_launch(void* const* d_in, const int* in_sizes, int n_in, void* d_out, int out_size,
                              void* d_ws, size_t ws_size, hipStream_t stream) {
  P p{};
  p.x = (const float*)d_in[0]; p.ln0g = (const float*)d_in[1]; p.ln0b = (const float*)d_in[2];
  p.w_in = (const float*)d_in[3]; p.b_gate = (const float*)d_in[4]; p.qng = (const float*)d_in[5]; p.kng = (const float*)d_in[6];
  p.w_bf = (const float*)d_in[7]; p.w_ba = (const float*)d_in[8]; p.w_out = (const float*)d_in[9];
  p.ln1g = (const float*)d_in[10]; p.ln1b = (const float*)d_in[11]; p.w_q = (const float*)d_in[12]; p.sk = (const float*)d_in[13];
  p.pu = (const float*)d_in[14]; p.pv = (const float*)d_in[15]; p.ln2g = (const float*)d_in[16]; p.ln2b = (const float*)d_in[17];
  p.out = (float*)d_out;
  char* w = (char*)d_ws;
  size_t off = 0;
  auto take = [&](size_t bytes) { char* r = w + off; off += (bytes + 255) & ~(size_t)255; return r; };
  p.WIN = (u16*)take((size_t)2 * 3328 * 1024 * 2);
  p.WBF = (u16*)take((size_t)2 * 1024 * 512 * 2);
  p.WBA = (u16*)take((size_t)2 * 1024 * 512 * 2);
  p.WOUT = (u16*)take((size_t)2 * 1024 * 1024 * 2);
  p.WQ = (u16*)take((size_t)2 * 2048 * 1024 * 2);
  p.SK = (u16*)take((size_t)2 * 8 * 2 * 128 * 128 * 2);
  p.U8 = (unsigned char*)take((size_t)2 * 16384 * 1024);
  p.V8 = (unsigned char*)take((size_t)2 * 16384 * 1024);
  p.SU = (float*)take((size_t)2 * 16384 * 4);
  p.SV = (float*)take((size_t)2 * 16384 * 4);
  p.D256 = (u16*)take(256 * 256 * 2);
  p.C64 = (u16*)take(64 * 128 * 2);
  p.TW = (float2*)take(128 * 64 * 8);
  p.ROPE = (float2*)take(128 * 16 * 8);
  p.XS = (float*)take((size_t)T * 1024 * 4);
  p.XB = (u16*)take((size_t)T * 1024 * 2);
  p.ZT = (u16*)take((size_t)33280 * 256 * 2);
  p.GP = (u16*)take((size_t)66560 * 128 * 2);
  p.Y = (u16*)take((size_t)T * 512 * 2);
  p.Q = (u16*)take((size_t)T * 512 * 2);
  p.K = (u16*)take((size_t)T * 128 * 2);
  p.VT = (u16*)take((size_t)T * 128 * 2);
  p.AO = (u16*)take((size_t)T * 512 * 2);
  p.GATES = (u16*)take((size_t)T * 2048 * 2);
  p.QP = p.GATES;
  p.MIXED = (u16*)take((size_t)T * 1024 * 2);
  p.BAR = (unsigned*)take(XCD_BAR_WORDS * 4);
  if (off > ws_size) { fprintf(stderr, "workspace too small: need %zu have %zu\n", off, ws_size); return; }

  static int grid_blocks = 0;
  if (!grid_blocks) {
    int dev = 0, cus = 0, per_cu = 0;
    (void)hipGetDevice(&dev);
    (void)hipDeviceGetAttribute(&cus, hipDeviceAttributeMultiprocessorCount, dev);
    (void)hipFuncSetAttribute((const void*)mega_kernel, hipFuncAttributeMaxDynamicSharedMemorySize, SMEM_BYTES);
    (void)hipOccupancyMaxActiveBlocksPerMultiprocessor(&per_cu, mega_kernel, NTHR, SMEM_BYTES);
    if (per_cu < 1) per_cu = 1;
    grid_blocks = cus;
  }
  (void)hipMemsetAsync(p.BAR, 0, XCD_BAR_WORDS * 4, stream);
  void* args[] = {&p};
  hipError_t e = hipLaunchCooperativeKernel((void*)mega_kernel, dim3(grid_blocks), dim3(NTHR), args, SMEM_BYTES, stream);
  if (e != hipSuccess) fprintf(stderr, "cooperative launch failed: %s (grid %d)\n", hipGetErrorString(e), grid_blocks);
}
```

```cpp
#include <hip/hip_runtime.h>
#include <hip/hip_cooperative_groups.h>
#include <cstdio>
namespace cg = cooperative_groups;


typedef unsigned short u16;
using bf16x8 = __attribute__((ext_vector_type(8))) short;
using s16x4  = __attribute__((ext_vector_type(4))) short;
using f32x16 = __attribute__((ext_vector_type(16))) float;
using u32x4  = __attribute__((ext_vector_type(4))) unsigned;
using f32x2  = __attribute__((ext_vector_type(2))) float;
#define DI __device__ __forceinline__
#define MFMA(a, b, c) __builtin_amdgcn_mfma_f32_32x32x16_bf16((a), (b), (c), 0, 0, 0)

constexpr int T = 16384;
constexpr float ALPHA = 1.4142135623730951f;
constexpr int NTHR = 512;
constexpr int VSMEM = 73728;
constexpr int SMEM_BYTES = 2 * VSMEM;

struct P {
  const float *x, *ln0g, *ln0b, *w_in, *b_gate, *qng, *kng, *w_bf, *w_ba, *w_out, *ln1g, *ln1b, *w_q, *sk, *pu, *pv, *ln2g, *ln2b;
  float* out;
  u16 *WIN, *WBF, *WBA, *WOUT, *WQ, *SK, *D256, *C64;
  float2 *TW, *ROPE;
  float* XS;
  u16 *XB, *ZT, *GP, *Y, *Q, *K, *VT, *AO, *GATES, *MIXED, *QP;
  unsigned* BAR;
  unsigned char *U8, *V8;
  float *SU, *SV;
};

DI u16 f2bf(float f) { __bf16 h = (__bf16)f; return __builtin_bit_cast(u16, h); }
DI float bf2f(u16 h) { return __uint_as_float(((unsigned)h) << 16); }
DI unsigned pack2(float a, float b) { return (unsigned)f2bf(a) | ((unsigned)f2bf(b) << 16); }
DI float bflo(unsigned u) { return __uint_as_float(u << 16); }
DI float bfhi(unsigned u) { return __uint_as_float(u & 0xffff0000u); }
#define LAS __attribute__((address_space(3)))
DI int hw_slot() { return __builtin_amdgcn_s_getreg((5 << 11) | 4) & 63; }
DI volatile LAS int* wmap() { __shared__ int wm_[64]; return (volatile LAS int*)wm_; }
DI int lane_id() { int l; asm volatile("v_mbcnt_lo_u32_b32 %0, -1, 0\n\tv_mbcnt_hi_u32_b32 %0, -1, %0" : "=&v"(l)); return l; }
DI int opaque_tid() { int w = wmap()[hw_slot()]; int t = (w << 6) | lane_id(); asm volatile("" : "+v"(t)); return t; }
DI int opaque_vtid() { return opaque_tid() & 255; }
template <int M> DI int shxi(int v) {
  if constexpr (M < 32) return __builtin_amdgcn_ds_swizzle(v, (M << 10) | 0x1f);
  else { int a = (lane_id() ^ 32) << 2; asm volatile("" : "+v"(a)); return __builtin_amdgcn_ds_bpermute(a, v); }
}
template <int M> DI float shx(float v) { return __int_as_float(shxi<M>(__float_as_int(v))); }
DI float wave_sum(float v) {
  v += shx<32>(v); v += shx<16>(v); v += shx<8>(v); v += shx<4>(v); v += shx<2>(v); v += shx<1>(v);
  return v;
}

template <int MT>
DI void gemm_main(const u16* __restrict__ A, long lda, const u16* __restrict__ B, long ldb, int K,
                  f32x16 (&acc)[MT][2], char* smem, const int  , const int rot = 0) {
  constexpr int STAGE = (64 * MT + 256) * 72;
  u16* s0 = (u16*)smem;
  const int tid = opaque_tid();
  const int lane = tid & 63, wave = tid >> 6;
  const int wm = wave >> 2, wn = wave & 3;
  const int lr = tid >> 3, lc = (tid & 7) * 8;
  const u16* Ap = A + (long)lr * lda + lc;
  const u16* Bp = B + (long)lr * ldb + lc;
  u32x4 ra[MT], rb[4];
  const int nk = K >> 6;
#define G_LOAD(kt)                                                                                      \
  _Pragma("unroll") for (int c = 0; c < MT; c++) ra[c] = *(const u32x4*)(Ap + (long)(64 * c) * lda + (((kt) + rot) & (nk - 1)) * 64); \
  _Pragma("unroll") for (int c = 0; c < 4; c++) rb[c] = *(const u32x4*)(Bp + (long)(64 * c) * ldb + (((kt) + rot) & (nk - 1)) * 64);
#define G_STORE(st)                                                                                     \
  { u16* sA_ = s0 + (st) * STAGE; u16* sB_ = sA_ + 64 * MT * 72;                                        \
    _Pragma("unroll") for (int c = 0; c < MT; c++) *(u32x4*)(sA_ + (lr + 64 * c) * 72 + lc) = ra[c];    \
    _Pragma("unroll") for (int c = 0; c < 4; c++) *(u32x4*)(sB_ + (lr + 64 * c) * 72 + lc) = rb[c]; }
#define G_COMPUTE(st)                                                                                   \
  { const u16* sA_ = s0 + (st) * STAGE; const u16* sB_ = sA_ + 64 * MT * 72;                            \
    _Pragma("unroll") for (int kk = 0; kk < 4; kk++) {                                                  \
      bf16x8 af[MT], bfr[2];                                                                            \
      _Pragma("unroll") for (int i = 0; i < MT; i++) af[i] = *(const bf16x8*)(sA_ + (wm * 32 * MT + i * 32 + (lane & 31)) * 72 + kk * 16 + (lane >> 5) * 8); \
      _Pragma("unroll") for (int j = 0; j < 2; j++) bfr[j] = *(const bf16x8*)(sB_ + (wn * 64 + j * 32 + (lane & 31)) * 72 + kk * 16 + (lane >> 5) * 8);     \
      _Pragma("unroll") for (int i = 0; i < MT; i++)                                                    \
        _Pragma("unroll") for (int j = 0; j < 2; j++) acc[i][j] = MFMA(af[i], bfr[j], acc[i][j]);       \
      if (MT > 2) __builtin_amdgcn_sched_barrier(0);                                                    \
    } }
  G_LOAD(0)
  __syncthreads();
  G_STORE(0)
  G_LOAD((1 < nk ? 1 : 0))
  __syncthreads();
  const bool late = __builtin_amdgcn_readfirstlane(wave) >= 4;
  for (int t = 0; t < nk; t++) {
    if (!late) {
      if (t + 1 < nk) { G_STORE((t + 1) & 1) }
      if (t + 2 < nk) { G_LOAD(t + 2) }
    }
    __builtin_amdgcn_s_setprio(1);
    G_COMPUTE(t & 1)
    __builtin_amdgcn_s_setprio(0);
    if (late) {
      if (t + 1 < nk) { G_STORE((t + 1) & 1) }
      if (t + 2 < nk) { G_LOAD(t + 2) }
    }
    __syncthreads();
  }
#undef G_LOAD
#undef G_STORE
#undef G_COMPUTE
}

struct Xcd { int id, slot, n; };
#define XCD_TILE_LOOP(MTOT, NTOT, mt, nt)                                             \
  for (int j_ = xc.slot, mt, nt; j_ < ((MTOT) / 8) * (NTOT) && (mt = xc.id * ((MTOT) / 8) + j_ % ((MTOT) / 8), nt = j_ / ((MTOT) / 8), true); j_ += xc.n)

template <int MT>
DI void zero_acc(f32x16 (&acc)[MT][2]) {
#pragma unroll
  for (int i = 0; i < MT; i++)
#pragma unroll
    for (int j = 0; j < 2; j++)
#pragma unroll
      for (int r = 0; r < 16; r++) acc[i][j][r] = 0.f;
}

DI void stage_q(f32x16 (&acc)[4][2], float* sC, const int tid, const int mh, const int nh) {
  const int lane = tid & 63, wave = tid >> 6, wm = wave >> 2, wn = wave & 3;
  if (wm == mh && (wn >> 1) == nh) {
#pragma unroll
    for (int i = 0; i < 4; i++)
#pragma unroll
      for (int j = 0; j < 2; j++)
#pragma unroll
        for (int r = 0; r < 16; r++) {
          int row = i * 32 + 8 * (r >> 2) + 4 * (lane >> 5) + (r & 3);
          int col = (wn & 1) * 64 + j * 32 + (lane & 31);
          sC[row * 132 + col] = acc[i][j][r];
        }
  }
  __syncthreads();
}
DI void stage_q_tr(f32x16 (&acc)[4][2], float* sC, const int tid, const int mh, const int nh) {
  const int lane = tid & 63, wave = tid >> 6, wm = wave >> 2, wn = wave & 3;
  if (wm == mh && (wn >> 1) == nh) {
#pragma unroll
    for (int i = 0; i < 4; i++)
#pragma unroll
      for (int j = 0; j < 2; j++)
#pragma unroll
        for (int rq = 0; rq < 4; rq++) {
          int row = i * 32 + 8 * rq + 4 * (lane >> 5);
          int col = (wn & 1) * 64 + j * 32 + (lane & 31);
          float4 v = make_float4(acc[i][j][rq * 4], acc[i][j][rq * 4 + 1], acc[i][j][rq * 4 + 2], acc[i][j][rq * 4 + 3]);
          *(float4*)(sC + col * 132 + row) = v;
        }
  }
  __syncthreads();
}
DI void unstage_q(f32x16 (&acc)[4][2], const float* sC, const int tid, const int mh, const int nh) {
  const int lane = tid & 63, wave = tid >> 6, wm = wave >> 2, wn = wave & 3;
  if (wm == mh && (wn >> 1) == nh) {
#pragma unroll
    for (int i = 0; i < 4; i++)
#pragma unroll
      for (int j = 0; j < 2; j++)
#pragma unroll
        for (int r = 0; r < 16; r++) {
          int row = i * 32 + 8 * (r >> 2) + 4 * (lane >> 5) + (r & 3);
          int col = (wn & 1) * 64 + j * 32 + (lane & 31);
          acc[i][j][r] = sC[row * 132 + col];
        }
  }
  __syncthreads();
}
DI void stage_h1(f32x16 (&acc)[1][2], float* sC, const int tid, const int nh) {
  const int lane = tid & 63, wave = tid >> 6, wm = wave >> 2, wn = wave & 3;
  if ((wn >> 1) == nh) {
#pragma unroll
    for (int j = 0; j < 2; j++)
#pragma unroll
      for (int r = 0; r < 16; r++) {
        int row = wm * 32 + 8 * (r >> 2) + 4 * (lane >> 5) + (r & 3);
        int col = (wn & 1) * 64 + j * 32 + (lane & 31);
        sC[row * 132 + col] = acc[0][j][r];
      }
  }
  __syncthreads();
}

DI void ln16_write(float (&v)[16], const float* g, const float* bt, float* dstf, u16* dstb, int lane) {
  float s = 0.f;
#pragma unroll
  for (int i = 0; i < 16; i++) s += v[i];
  float mu = wave_sum(s) * (1.f / 1024.f);
  float q = 0.f;
#pragma unroll
  for (int i = 0; i < 16; i++) { float d = v[i] - mu; q += d * d; }
  float rstd = rsqrtf(wave_sum(q) * (1.f / 1024.f) + 1e-5f);
#pragma unroll
  for (int c = 0; c < 4; c++) {
    int e = (lane + 64 * c) * 4;
    float4 gg = *(const float4*)(g + e), bb = *(const float4*)(bt + e);
    float4 o;
    o.x = (v[c * 4 + 0] - mu) * rstd * gg.x + bb.x;
    o.y = (v[c * 4 + 1] - mu) * rstd * gg.y + bb.y;
    o.z = (v[c * 4 + 2] - mu) * rstd * gg.z + bb.z;
    o.w = (v[c * 4 + 3] - mu) * rstd * gg.w + bb.w;
    if (dstf) *(float4*)(dstf + e) = o;
    if (dstb) { uint2 pk; pk.x = pack2(o.x, o.y); pk.y = pack2(o.z, o.w); *(uint2*)(dstb + e) = pk; }
  }
}

DI void transpose_tile(const float* __restrict__ src, int ldsrc, u16* __restrict__ dst, int lddst, float* tile  , const int tid, const bool act) {
  __syncthreads();
#pragma unroll
  for (int i = 0; i < 4; i++) {
    int r = (tid >> 4) + 16 * i, c4 = (tid & 15) * 4;
    float4 v = *(const float4*)(src + (long)r * ldsrc + c4);
    tile[r * 65 + c4] = v.x; tile[r * 65 + c4 + 1] = v.y; tile[r * 65 + c4 + 2] = v.z; tile[r * 65 + c4 + 3] = v.w;
  }
  __syncthreads();
#pragma unroll
  for (int i = 0; i < 2; i++) {
    int unit = tid + 256 * i, n = unit >> 3, ch = unit & 7;
    uint4 o;
    o.x = pack2(tile[(ch * 8 + 0) * 65 + n], tile[(ch * 8 + 1) * 65 + n]);
    o.y = pack2(tile[(ch * 8 + 2) * 65 + n], tile[(ch * 8 + 3) * 65 + n]);
    o.z = pack2(tile[(ch * 8 + 4) * 65 + n], tile[(ch * 8 + 5) * 65 + n]);
    o.w = pack2(tile[(ch * 8 + 6) * 65 + n], tile[(ch * 8 + 7) * 65 + n]);
    if (act) *(uint4*)(dst + (long)n * lddst + ch * 8) = o;
  }
}

DI void ph_prep(const P& p, char* smem, int bid, int nb) {
  constexpr int VT = 256;
  const int tid = opaque_vtid(), lane = tid & 63, wave = tid >> 6;
  for (int row = bid * 4 + wave; row < T; row += nb * 4) {
    const float* src = p.x + (long)row * 1024;
    float v[16];
#pragma unroll
    for (int c = 0; c < 4; c++) { float4 t = *(const float4*)(src + (lane + 64 * c) * 4); v[c * 4] = t.x; v[c * 4 + 1] = t.y; v[c * 4 + 2] = t.z; v[c * 4 + 3] = t.w; }
    int b = row >> 13, s = row & 8191;
    int tp = (b << 13) + (s & 63) * 128 + (s >> 6);
    ln16_write(v, p.ln0g, p.ln0b, p.XS + (long)tp * 1024, p.XB + (long)tp * 1024, lane);
  }
  for (int r = bid * 4 + wave; r < 65536; r += nb * 4) {
    const int tb = r >> 15, rr = r & 32767;
    const float* src = (tb ? p.pv : p.pu) + (long)rr * 1024;
    float v[16];
#pragma unroll
    for (int c = 0; c < 4; c++) { float4 t = *(const float4*)(src + (lane + 64 * c) * 4); v[c * 4] = t.x; v[c * 4 + 1] = t.y; v[c * 4 + 2] = t.z; v[c * 4 + 3] = t.w; }
    float am = 0.f;
#pragma unroll
    for (int i = 0; i < 16; i++) am = fmaxf(am, fabsf(v[i]));
    { am = fmaxf(am, shx<32>(am)); am = fmaxf(am, shx<16>(am)); am = fmaxf(am, shx<8>(am)); am = fmaxf(am, shx<4>(am)); am = fmaxf(am, shx<2>(am)); am = fmaxf(am, shx<1>(am)); }
    const float inv = am > 0.f ? 127.f / am : 0.f;
    unsigned char* dst = (tb ? p.V8 : p.U8) + (long)rr * 1024;
#pragma unroll
    for (int c = 0; c < 4; c++) {
      unsigned q0 = (unsigned)((int)rintf(v[c * 4] * inv) + 128), q1 = (unsigned)((int)rintf(v[c * 4 + 1] * inv) + 128);
      unsigned q2 = (unsigned)((int)rintf(v[c * 4 + 2] * inv) + 128), q3 = (unsigned)((int)rintf(v[c * 4 + 3] * inv) + 128);
      *(unsigned*)(dst + (lane + 64 * c) * 4) = q0 | (q1 << 8) | (q2 << 16) | (q3 << 24);
    }
    if (lane == 0) (tb ? p.SV : p.SU)[rr] = am * (1.f / 127.f);
  }
  for (int i = bid * VT + tid; i < 2 * 8 * 2 * 128 * 128 / 8; i += nb * VT) {
    const float* s = p.sk + (long)i * 8;
    float4 a = *(const float4*)s, b = *(const float4*)(s + 4);
    uint4 o; o.x = pack2(a.x, a.y); o.y = pack2(a.z, a.w); o.z = pack2(b.x, b.y); o.w = pack2(b.z, b.w);
    *(uint4*)(p.SK + (long)i * 8) = o;
  }
  {
    float* tile = (float*)smem;
    const int per_layer = 704 + 128 + 128 + 256 + 512;
    for (int it0 = 0; it0 < 2 * per_layer; it0 += nb) {
      int it = it0 + bid; const bool act = it < 2 * per_layer; if (!act) it = 0;
      int l = it / per_layer, r = it % per_layer;
      const float* src; u16* dst; int ldsrc, lddst, kt, nt;
      if (r < 704) { kt = r / 44; nt = r % 44; src = p.w_in + (long)l * 1024 * 3328 + 512; ldsrc = 3328; dst = p.WIN + ((long)l * 3328 + 512) * 1024; lddst = 1024; }
      else if (r < 832) { r -= 704; kt = r / 16; nt = r % 16; src = p.w_bf + (long)l * 512 * 1024; ldsrc = 1024; dst = p.WBF + (long)l * 1024 * 512; lddst = 512; }
      else if (r < 960) { r -= 832; kt = r / 16; nt = r % 16; src = p.w_ba + (long)l * 512 * 1024; ldsrc = 1024; dst = p.WBA + (long)l * 1024 * 512; lddst = 512; }
      else if (r < 1216) { r -= 960; kt = r / 16; nt = r % 16; src = p.w_out + (long)l * 1024 * 1024; ldsrc = 1024; dst = p.WOUT + (long)l * 1024 * 1024; lddst = 1024; }
      else { r -= 1216; kt = r / 32; nt = r % 32; src = p.w_q + (long)l * 1024 * 2048; ldsrc = 2048; dst = p.WQ + (long)l * 2048 * 1024; lddst = 1024; }
      transpose_tile(src + (long)kt * 64 * ldsrc + nt * 64, ldsrc, dst + (long)nt * 64 * lddst + kt * 64, lddst, tile, tid, act);
    }
    __syncthreads();
  }
  {
    float* wt = (float*)smem;
    float* ctab = wt + 16 * 128;
    if (tid < 128) ctab[tid] = cospif((float)tid / 64.f);
    for (int it0 = 0; it0 < 2 * 4 * 64; it0 += nb) {
      int it = it0 + bid; const bool act = it < 2 * 4 * 64; if (!act) it = 0;
      int l = it >> 8, g = (it >> 6) & 3, kt = it & 63;
      __syncthreads();
      for (int e = tid; e < 16 * 32; e += VT) {
        int kr = e >> 5, c4 = (e & 31) * 4;
        *(float4*)(wt + kr * 128 + c4) = *(const float4*)(p.w_in + ((long)l * 1024 + kt * 16 + kr) * 3328 + g * 128 + c4);
      }
      __syncthreads();
      int j = tid & 127, kh = tid >> 7;
      int cp, off; float sgn;
      if (j < 65) { cp = j; off = 0; sgn = 0.08838834764831845f; } else { cp = j - 64; off = 96; sgn = -0.08838834764831845f; }
      float a[8];
#pragma unroll
      for (int q = 0; q < 8; q++) a[q] = 0.f;
      for (int d = 0; d < 128; d++) {
        float bs = ctab[(cp * d + off) & 127];
#pragma unroll
        for (int q = 0; q < 8; q++) a[q] += wt[(kh * 8 + q) * 128 + d] * bs;
      }
      uint4 o; o.x = pack2(a[0] * sgn, a[1] * sgn); o.y = pack2(a[2] * sgn, a[3] * sgn); o.z = pack2(a[4] * sgn, a[5] * sgn); o.w = pack2(a[6] * sgn, a[7] * sgn);
      if (act) *(uint4*)(p.WIN + ((long)l * 3328 + g * 128 + j) * 1024 + kt * 16 + kh * 8) = o;
    }
    __syncthreads();
  }
  for (int i = bid * VT + tid; i < 65536; i += nb * VT) {
    int m = i >> 8, kk = i & 255;
    int mh = m >> 7, po = (m >> 6) & 1, k1 = mh * 64 + (m & 63);
    int pi = kk >> 7, s1 = kk & 127;
    int a = (k1 * s1) & 127;
    float c = cospif((float)a / 64.f), s = sinpif((float)a / 64.f);
    float v = (po == pi) ? c : (po == 0 ? s : -s);
    p.D256[i] = f2bf(v * 0.08838834764831845f);
  }
  for (int i = bid * VT + tid; i < 8192; i += nb * VT) {
    int k2 = i >> 7, kk = i & 127, pi = kk >> 6, s2 = kk & 63;
    int a = (k2 * s2) & 63;
    float v = pi ? sinpif((float)a / 32.f) : cospif((float)a / 32.f);
    p.C64[i] = f2bf(v * 0.125f);
    int k1 = i >> 6, t2 = i & 63;
    float ph = (float)(k1 * t2) / 4096.f;
    p.TW[i] = make_float2(cospif(ph), sinpif(ph));
  }
  for (int i = bid * VT + tid; i < 2048; i += nb * VT) {
    int pos = i >> 4, f = i & 15;
    float inv = 1.0f / powf(10000.f, (float)(2 * f) / 32.f);
    float ang = (float)pos * inv;
    p.ROPE[i] = make_float2(cosf(ang), sinf(ang));
  }
}

DI void inproj_epi_fourier(const P& p, const float* sC, int mt, int g, const int tid) {
  const int b = mt >> 6, s2 = mt & 63;
#pragma unroll 1
  for (int unit = tid; unit < 2048; unit += NTHR) {
    int j = unit >> 4, ch = unit & 15;
    float4 a = *(const float4*)(sC + j * 132 + ch * 8), c = *(const float4*)(sC + j * 132 + ch * 8 + 4);
    uint4 o; o.x = pack2(a.x, a.y); o.y = pack2(a.z, a.w); o.z = pack2(c.x, c.y); o.w = pack2(c.z, c.w);
    int cp = (j < 65) ? j : j - 64, part = (j < 65) ? 0 : 1;
    long rowi = ((long)(b * 4 + g) * 65 + cp) * 64 + s2;
    *(uint4*)(p.ZT + rowi * 256 + part * 128 + ch * 8) = o;
  }
  if (tid < 32) {
    int cp = (tid < 16) ? 0 : 64, ch = tid & 15;
    long rowi = ((long)(b * 4 + g) * 65 + cp) * 64 + s2;
    unsigned z_; asm volatile("v_mov_b32 %0, 0" : "=v"(z_));
    *(uint4*)(p.ZT + rowi * 256 + 128 + ch * 8) = make_uint4(z_, z_, z_, z_);
  }
}
DI void inproj_epi_qk(const P& p, int l, const float* sC, int mt, int nt, const int tid) {
  const int b = mt >> 6, s2 = mt & 63;
  if (tid < 256) {
    const int row = tid & 127, hd = tid >> 7;
    const float* sr = sC + row * 132 + hd * 64;
    float ss = 0.f;
#pragma unroll
    for (int i = 0; i < 16; i++) { float4 t = *(const float4*)(sr + i * 4); ss += t.x * t.x + t.y * t.y + t.z * t.z + t.w * t.w; }
    const bool isq = nt < 8;
    const float* gn = (isq ? p.qng : p.kng) + l * 64;
    const float rinv = rsqrtf(ss * (1.f / 64.f) + 1e-6f) * (isq ? (0.125f * 1.4426950408889634f) : 1.f);
    const int s1 = row;
    const int u = s2 * 128 + s1;
    u16* dst;
    if (isq) { int h = (nt - 4) * 2 + hd; dst = p.Q + ((long)(b * 8 + h) * 8192 + u) * 64; }
    else { dst = p.K + ((long)(b * 2 + hd) * 8192 + u) * 64; }
#pragma unroll 1
    for (int ax = 0; ax < 2; ax++) {
      const int pos = ax ? s2 : s1;
#pragma unroll 1
      for (int fq = 0; fq < 2; fq++) {
        float x0[8], x1[8], o0[8], o1[8];
#pragma unroll
        for (int e = 0; e < 8; e++) {
          int d0 = ax * 32 + fq * 8 + e, d1 = d0 + 16;
          x0[e] = sr[d0] * rinv * gn[d0];
          x1[e] = sr[d1] * rinv * gn[d1];
          float2 cs = p.ROPE[pos * 16 + fq * 8 + e];
          o0[e] = x0[e] * cs.x - x1[e] * cs.y;
          o1[e] = x1[e] * cs.x + x0[e] * cs.y;
        }
        uint4 pk;
        pk.x = pack2(o0[0], o0[1]); pk.y = pack2(o0[2], o0[3]); pk.z = pack2(o0[4], o0[5]); pk.w = pack2(o0[6], o0[7]);
        *(uint4*)(dst + ax * 32 + fq * 8) = pk;
        pk.x = pack2(o1[0], o1[1]); pk.y = pack2(o1[2], o1[3]); pk.z = pack2(o1[4], o1[5]); pk.w = pack2(o1[6], o1[7]);
        *(uint4*)(dst + ax * 32 + 16 + fq * 8) = pk;
      }
    }
  }
}
DI void inproj_epi_v(const P& p, const float* sC, int mt, const int tid) {
  const int b = mt >> 6, s2 = mt & 63;
#pragma unroll 1
  for (int unit = tid; unit < 2048; unit += NTHR) {
    int j = unit >> 4, ch = unit & 15;
    float4 a = *(const float4*)(sC + j * 132 + ch * 8), c = *(const float4*)(sC + j * 132 + ch * 8 + 4);
    uint4 o; o.x = pack2(a.x, a.y); o.y = pack2(a.z, a.w); o.z = pack2(c.x, c.y); o.w = pack2(c.z, c.w);
    *(uint4*)(p.VT + ((long)(b * 2) * 64 + j) * 8192 + s2 * 128 + ch * 8) = o;
  }
}
DI void inproj_epi_gates(const P& p, int l, const float* sC, int mt, int nt, const int tid) {
  const int c0 = (nt - 10) * 128;
  const float* bg = p.b_gate + l * 2048 + c0;
#pragma unroll 1
  for (int unit = tid; unit < 2048; unit += NTHR) {
    int row = unit >> 4, ch = unit & 15;
    float4 a = *(const float4*)(sC + row * 132 + ch * 8), c = *(const float4*)(sC + row * 132 + ch * 8 + 4);
    float4 ba = *(const float4*)(bg + ch * 8), bc = *(const float4*)(bg + ch * 8 + 4);
    float r0 = 1.f / (1.f + __expf(-(a.x + ba.x))), r1 = 1.f / (1.f + __expf(-(a.y + ba.y)));
    float r2 = 1.f / (1.f + __expf(-(a.z + ba.z))), r3 = 1.f / (1.f + __expf(-(a.w + ba.w)));
    float r4 = 1.f / (1.f + __expf(-(c.x + bc.x))), r5 = 1.f / (1.f + __expf(-(c.y + bc.y)));
    float r6 = 1.f / (1.f + __expf(-(c.z + bc.z))), r7 = 1.f / (1.f + __expf(-(c.w + bc.w)));
    uint4 o; o.x = pack2(r0, r1); o.y = pack2(r2, r3); o.z = pack2(r4, r5); o.w = pack2(r6, r7);
    *(uint4*)(p.GATES + ((long)mt * 128 + row) * 2048 + c0 + ch * 8) = o;
  }
}

DI void ph_inproj(const P& p, int l, char* smem, int bid, int nb, const Xcd xc) {
  const int tid = opaque_tid();
  float* sC = (float*)smem;
  const u16* W = p.WIN + (long)l * 3328 * 1024;
  XCD_TILE_LOOP(64, 12, mt2, nt2) {
    f32x16 acc[4][2];
    zero_acc<4>(acc);
    gemm_main<4>(p.XB + (long)mt2 * 256 * 1024, 1024, W + (long)nt2 * 256 * 1024, 1024, 1024, acc, smem, tid, 0);
#pragma unroll 1
    for (int q = 0; q < 4; q++) {
      const int mh = q >> 1, nh = q & 1, mt = mt2 * 2 + mh, nt = nt2 * 2 + nh;
      if (nt < 4) { stage_q_tr(acc, sC, tid, mh, nh); inproj_epi_fourier(p, sC, mt, nt, opaque_tid()); }
      else if (nt < 9) { stage_q(acc, sC, tid, mh, nh); inproj_epi_qk(p, l, sC, mt, nt, opaque_tid()); }
      else if (nt == 9) { stage_q_tr(acc, sC, tid, mh, nh); inproj_epi_v(p, sC, mt, opaque_tid()); }
      else { stage_q(acc, sC, tid, mh, nh); inproj_epi_gates(p, l, sC, mt, nt, opaque_tid()); }
      __syncthreads();
    }
  }
  for (int j_ = xc.slot; j_ < 32; j_ += xc.n) {
    const int mt4 = xc.id * 32 + j_;
    f32x16 acc1[1][2];
    zero_acc<1>(acc1);
    gemm_main<1>(p.XB + (long)mt4 * 64 * 1024, 1024, W + (long)12 * 256 * 1024, 1024, 1024, acc1, smem, tid, 0);
#pragma unroll 1
    for (int nh = 0; nh < 2; nh++) {
      stage_h1(acc1, sC, tid, nh);
      const int c0 = (24 + nh - 10) * 128;
      const float* bg = p.b_gate + l * 2048 + c0;
#pragma unroll 1
      for (int unit = opaque_tid(); unit < 1024; unit += NTHR) {
        int row = unit >> 4, ch = unit & 15;
        float4 a = *(const float4*)(sC + row * 132 + ch * 8), c = *(const float4*)(sC + row * 132 + ch * 8 + 4);
        float4 ba = *(const float4*)(bg + ch * 8), bc = *(const float4*)(bg + ch * 8 + 4);
        float r0 = 1.f / (1.f + __expf(-(a.x + ba.x))), r1 = 1.f / (1.f + __expf(-(a.y + ba.y)));
        float r2 = 1.f / (1.f + __expf(-(a.z + ba.z))), r3 = 1.f / (1.f + __expf(-(a.w + ba.w)));
        float r4 = 1.f / (1.f + __expf(-(c.x + bc.x))), r5 = 1.f / (1.f + __expf(-(c.y + bc.y)));
        float r6 = 1.f / (1.f + __expf(-(c.z + bc.z))), r7 = 1.f / (1.f + __expf(-(c.w + bc.w)));
        uint4 o; o.x = pack2(r0, r1); o.y = pack2(r2, r3); o.z = pack2(r4, r5); o.w = pack2(r6, r7);
        *(uint4*)(p.GATES + ((long)mt4 * 64 + row) * 2048 + c0 + ch * 8) = o;
      }
      __syncthreads();
    }
  }
}

DI void ph_fftA(const P& p, char* smem, int bid, int nb) {
  const int tid = opaque_tid();
  float* sC = (float*)smem;
  for (int t2 = bid; t2 < 130; t2 += nb) {
    f32x16 acc[4][2];
    zero_acc<4>(acc);
    gemm_main<4>(p.D256, 256, p.ZT + (long)t2 * 256 * 256, 256, 256, acc, smem, tid, t2);
#pragma unroll 1
    for (int q = 0; q < 4; q++) {
      const int mh = q >> 1, nh = q & 1, ntile = t2 * 2 + nh;
      stage_q(acc, sC, tid, mh, nh);
      if (tid < 256) {
        const int k1l = tid & 63, ch = (tid >> 6) & 1, po = tid >> 7;
        const int k1 = mh * 64 + k1l;
        const int qd = ntile * 2 + ch, bg = qd / 65, cp = qd % 65;
        u16* dst = p.GP + (((long)bg * 128 + k1) * 65 + cp) * 128 + po * 64;
        const float2* tw = p.TW + k1 * 64;
#pragma unroll 2
        for (int i = 0; i < 8; i++) {
          float o[8];
#pragma unroll
          for (int e = 0; e < 8; e++) {
            int s2 = i * 8 + e;
            float gr = sC[k1l * 132 + ch * 64 + s2], gi = sC[(64 + k1l) * 132 + ch * 64 + s2];
            float2 cs = tw[s2];
            o[e] = po ? (gi * cs.x - gr * cs.y) : (gr * cs.x + gi * cs.y);
          }
          uint4 pk; pk.x = pack2(o[0], o[1]); pk.y = pack2(o[2], o[3]); pk.z = pack2(o[4], o[5]); pk.w = pack2(o[6], o[7]);
          *(uint4*)(dst + i * 8) = pk;
        }
      }
      __syncthreads();
    }
  }
}

DI void ph_fftC(const P& p, char* smem, int bid, int nb) {
  const int tid = opaque_tid();
  float* sC = (float*)smem;
  for (int t2 = bid; t2 < 260; t2 += nb) {
    f32x16 acc[1][2];
    zero_acc<1>(acc);
    gemm_main<1>(p.C64, 128, p.GP + (long)t2 * 256 * 128, 128, 128, acc, smem, tid, 0);
#pragma unroll 1
    for (int nh = 0; nh < 2; nh++) {
      stage_h1(acc, sC, tid, nh);
      const int tile = t2 * 2 + nh;
      const int nl = tid & 127, kh = tid >> 7;
      const int idx = tile * 128 + nl;
      const int cp = idx % 65, k1 = (idx / 65) & 127, bg = idx / (65 * 128);
      const int b = bg >> 2, g = bg & 3;
      const bool mir = (cp >= 1 && cp <= 63);
      for (int i = 0; i < 16; i++) {
        int k2 = kh * 16 + i;
        u16 v = f2bf(sC[k2 * 132 + nl]);
        int k = k1 + 128 * k2;
        long tp = (long)b * 8192 + (k & 63) * 128 + (k >> 6);
        p.Y[tp * 512 + g * 128 + cp] = v;
        if (mir) {
          int km = (8192 - k) & 8191;
          long tm = (long)b * 8192 + (km & 63) * 128 + (km >> 6);
          p.Y[tm * 512 + g * 128 + 128 - cp] = v;
        }
      }
      __syncthreads();
    }
  }
}

DI void attn_item(const P& p, int l, int item, char* smem, const int tid, const int rot, const bool late) {
  const int lane = tid & 63, wave = tid >> 6;
  const int hg = item & 3, qb = (item >> 2) & 31, kvh = (item >> 7) & 1, b = item >> 8;
  const int h = kvh * 4 + hg;
  const int ql = lane & 31, hf = lane >> 5;
  const u16* Qp = p.Q + ((long)(b * 8 + h) * 8192 + qb * 256 + wave * 64) * 64;
  const u16* Kp = p.K + (long)(b * 2 + kvh) * 8192 * 64;
  const u16* Vp = p.VT + (long)(b * 2 + kvh) * 64 * 8192;
  u16* sK = (u16*)smem;
  u16* sV = sK + 3 * 64 * 72;
  f32x16 o[2][2];
#pragma unroll
  for (int dt = 0; dt < 2; dt++)
#pragma unroll
    for (int qt = 0; qt < 2; qt++)
#pragma unroll
      for (int r = 0; r < 16; r++) o[dt][qt][r] = 0.f;
  f32x2 ls[2] = {f32x2{0.f, 0.f}, f32x2{0.f, 0.f}};
  const int lr = tid >> 3, lc = (tid & 7) * 8;
  u32x4 rk[2], rv[2];
  __syncthreads();
#pragma unroll
  for (int c = 0; c < 2; c++) {
    rk[c] = *(const u32x4*)((const char*)Kp + ((long)(rot & 127) * 8192 + c * 4096) + (unsigned)((lr * 64 + lc) * 2));
    rv[c] = *(const u32x4*)((const char*)Vp + ((long)(rot & 127) * 128 + (long)c * 32 * 8192 * 2) + (unsigned)((lr * 8192 + lc) * 2));
  }
#pragma unroll
  for (int c = 0; c < 2; c++) {
    *(u32x4*)(sK + (lr + 32 * c) * 72 + lc) = rk[c];
    *(u32x4*)(sV + (lr + 32 * c) * 72 + lc) = rv[c];
  }
  __syncthreads();
  __builtin_amdgcn_sched_barrier(0);
  bf16x8 qf[2][4];
  float bound[2];
  float kmax = fabsf(p.kng[l * 64 + lane]);
  { kmax = fmaxf(kmax, shx<32>(kmax)); kmax = fmaxf(kmax, shx<16>(kmax)); kmax = fmaxf(kmax, shx<8>(kmax)); kmax = fmaxf(kmax, shx<4>(kmax)); kmax = fmaxf(kmax, shx<2>(kmax)); kmax = fmaxf(kmax, shx<1>(kmax)); }
  kmax *= 8.f * 1.02f;
#pragma unroll
  for (int qt = 0; qt < 2; qt++) {
    float ssq = 0.f;
#pragma unroll
    for (int kd = 0; kd < 4; kd++) {
      qf[qt][kd] = *(const bf16x8*)((const char*)Qp + (long)((qt * 32 * 64 + kd * 16) * 2) + (unsigned)((ql * 64 + hf * 8) * 2));
#pragma unroll
      for (int j = 0; j < 8; j++) { float v = bf2f((u16)qf[qt][kd][j]); ssq += v * v; }
    }
    ssq += shx<32>(ssq);
    bound[qt] = sqrtf(ssq) * kmax;
    __builtin_amdgcn_sched_barrier(0);
  }
  const unsigned offK = (unsigned)((lr * 64 + lc) * 2), offV = (unsigned)((lr * 8192 + lc) * 2);
  const char* Kb = (const char*)Kp;
  const char* Vb = (const char*)Vp;
#define ATT_LOAD(ktile)                                                                                   \
  { const long tk_ = (long)(((ktile) + rot) & 127);                                                       \
    rk[0] = *(const u32x4*)(Kb + tk_ * 8192 + offK); rk[1] = *(const u32x4*)(Kb + (tk_ * 8192 + 4096) + offK);          \
    rv[0] = *(const u32x4*)(Vb + tk_ * 128 + offV);  rv[1] = *(const u32x4*)(Vb + (tk_ * 128 + 32 * 8192 * 2) + offV); }
#define ATT_STORE(buf3)                                                                                   \
  { u16* nK = sK + (buf3) * 64 * 72; u16* nV = sV + (buf3) * 64 * 72;                                     \
    _Pragma("unroll") for (int c = 0; c < 2; c++) {                                                       \
      *(u32x4*)(nK + (lr + 32 * c) * 72 + lc) = rk[c];                                                    \
      *(u32x4*)(nV + (lr + 32 * c) * 72 + lc) = rv[c];                                                    \
    } }
#define ATT_KS(ks)                                                                                        \
    {                                                                                                     \
      f32x16 st[2];                                                                                       \
      _Pragma("unroll") for (int qt = 0; qt < 2; qt++)                                                    \
        _Pragma("unroll") for (int r = 0; r < 16; r++) st[qt][r] = -bound[qt];                            \
      _Pragma("unroll") for (int kd = 0; kd < 4; kd++) {                                                  \
        bf16x8 kf = *(const bf16x8*)(cK + ((ks) * 32 + ql) * 72 + kd * 16 + hf * 8);                      \
        _Pragma("unroll") for (int qt = 0; qt < 2; qt++) st[qt] = MFMA(kf, qf[qt][kd], st[qt]);           \
      }                                                                                                   \
      _Pragma("unroll") for (int qt = 0; qt < 2; qt++)                                                    \
        _Pragma("unroll") for (int r = 0; r < 16; r += 2) {                                               \
          float e0 = __builtin_amdgcn_exp2f(st[qt][r]), e1 = __builtin_amdgcn_exp2f(st[qt][r + 1]);      \
          st[qt][r] = e0; st[qt][r + 1] = e1;                                                             \
          ls[qt] += f32x2{e0, e1};                                                                        \
        }                                                                                                 \
      _Pragma("unroll") for (int s = 0; s < 2; s++) {                                                     \
        bf16x8 pf[2];                                                                                     \
        _Pragma("unroll") for (int qt = 0; qt < 2; qt++)                                                  \
          _Pragma("unroll") for (int j = 0; j < 8; j++) pf[qt][j] = (short)f2bf(st[qt][8 * s + j]);       \
        _Pragma("unroll") for (int dt = 0; dt < 2; dt++) {                                                \
          const u16* vp = cV + (dt * 32 + ql) * 72 + (ks) * 32 + 16 * s + 4 * hf;                         \
          s16x4 lo = *(const s16x4*)vp, hi = *(const s16x4*)(vp + 8);                                     \
          bf16x8 vf = __builtin_shufflevector(lo, hi, 0, 1, 2, 3, 4, 5, 6, 7);                            \
          _Pragma("unroll") for (int qt = 0; qt < 2; qt++) o[dt][qt] = MFMA(vf, pf[qt], o[dt][qt]);       \
        }                                                                                                 \
      }                                                                                                   \
      __builtin_amdgcn_sched_barrier(0);                                                                  \
    }
  if (late) { ATT_LOAD(1) }
  int cur3 = 0;
  for (int kt = 0; kt < 128; kt++) {
    const int nxt3 = (cur3 == 2) ? 0 : cur3 + 1;
    const u16* cK = sK + cur3 * 64 * 72;
    const u16* cV = sV + cur3 * 64 * 72;
    if (!late) { if (kt + 1 < 128) { ATT_LOAD(kt + 1) } }
    ATT_KS(0)
    if (late) {
      if (kt + 1 < 128) { ATT_STORE(nxt3) }
      __syncthreads();
      if (kt + 2 < 128) { ATT_LOAD(kt + 2) }
    }
    ATT_KS(1)
    if (!late) {
      if (kt + 1 < 128) { ATT_STORE(nxt3) }
      __syncthreads();
    }
    cur3 = nxt3;
  }
  __syncthreads();
#undef ATT_LOAD
#undef ATT_STORE
#undef ATT_KS
  const int te_ = opaque_vtid();
  const int lane_e = te_ & 63, wave_e = te_ >> 6, ql_e = lane_e & 31, hf_e = lane_e >> 5;
  u16* sO = (u16*)smem + wave_e * 64 * 72;
#pragma unroll
  for (int qt = 0; qt < 2; qt++) {
    float lt = ls[qt].x + ls[qt].y;
    lt += shx<32>(lt);
    const float inv = 1.f / lt;
#pragma unroll
    for (int dt = 0; dt < 2; dt++)
#pragma unroll
      for (int rq = 0; rq < 4; rq++) {
        int d = dt * 32 + 8 * rq + 4 * hf_e;
        uint2 pk; pk.x = pack2(o[dt][qt][rq * 4] * inv, o[dt][qt][rq * 4 + 1] * inv); pk.y = pack2(o[dt][qt][rq * 4 + 2] * inv, o[dt][qt][rq * 4 + 3] * inv);
        *(uint2*)(sO + (qt * 32 + ql_e) * 72 + d) = pk;
      }
  }
  __syncthreads();
  u16* dst = p.AO + ((long)b * 8192 + qb * 256 + wave_e * 64) * 512 + h * 64;
#pragma unroll 2
  for (int i = 0; i < 8; i++) {
    int unit = lane_e + 64 * i, q = unit >> 3, ch = unit & 7;
    *(uint4*)(dst + (long)q * 512 + ch * 8) = *(const uint4*)(sO + q * 72 + ch * 8);
  }
  __syncthreads();
}

DI void ph_attn(const P& p, int l, char* smem, const Xcd xc, const int vb) {
  const int tid = opaque_vtid();
  for (int base = xc.slot * 2; base < 64; base += xc.n * 2) {
    const int sl = base + vb;
    attn_item(p, l, ((xc.id >> 1) << 7) | ((xc.id & 1) << 6) | sl, smem, tid, sl * 2, vb != 0);
  }
}

DI void ph_branch(const P& p, int l, char* smem, int bid, int nb, const Xcd xc) {
  const int tid = opaque_tid();
  float* sC = (float*)smem;
  XCD_TILE_LOOP(64, 4, mt2, nt2) {
    f32x16 a1[4][2];
    zero_acc<4>(a1);
    gemm_main<4>(p.Y + (long)mt2 * 256 * 512, 512, p.WBF + ((long)l * 1024 + nt2 * 256) * 512, 512, 512, a1, smem, tid, 0);
#pragma unroll 1
    for (int q = 0; q < 4; q++) {
      const int mh = q >> 1, nh = q & 1, mt = mt2 * 2 + mh, nt = nt2 * 2 + nh;
      stage_q(a1, sC, tid, mh, nh);
#pragma unroll 1
      for (int unit = opaque_tid(); unit < 2048; unit += NTHR) {
        int row = unit >> 4, ch = unit & 15;
        const u16* gp = p.GATES + ((long)mt * 128 + row) * 2048 + nt * 128 + ch * 8;
        uint4 gf = *(const uint4*)gp, ga = *(const uint4*)(gp + 1024);
        float* sp = sC + row * 132 + ch * 8;
        float4 a = *(const float4*)sp, c = *(const float4*)(sp + 4);
        a.x *= bflo(gf.x) / fmaxf(bflo(ga.x), 1e-20f); a.y *= bfhi(gf.x) / fmaxf(bfhi(ga.x), 1e-20f);
        a.z *= bflo(gf.y) / fmaxf(bflo(ga.y), 1e-20f); a.w *= bfhi(gf.y) / fmaxf(bfhi(ga.y), 1e-20f);
        c.x *= bflo(gf.z) / fmaxf(bflo(ga.z), 1e-20f); c.y *= bfhi(gf.z) / fmaxf(bfhi(ga.z), 1e-20f);
        c.z *= bflo(gf.w) / fmaxf(bflo(ga.w), 1e-20f); c.w *= bfhi(gf.w) / fmaxf(bfhi(ga.w), 1e-20f);
        *(float4*)sp = a; *(float4*)(sp + 4) = c;
      }
      __syncthreads();
      unstage_q(a1, sC, tid, mh, nh);
    }
    gemm_main<4>(p.AO + (long)mt2 * 256 * 512, 512, p.WBA + ((long)l * 1024 + nt2 * 256) * 512, 512, 512, a1, smem, tid, 0);
#pragma unroll 1
    for (int q = 0; q < 4; q++) {
      const int mh = q >> 1, nh = q & 1, mt = mt2 * 2 + mh, nt = nt2 * 2 + nh;
      stage_q(a1, sC, tid, mh, nh);
#pragma unroll 1
      for (int unit = opaque_tid(); unit < 2048; unit += NTHR) {
        int row = unit >> 4, ch = unit & 15;
        uint4 ga = *(const uint4*)(p.GATES + ((long)mt * 128 + row) * 2048 + 1024 + nt * 128 + ch * 8);
        float4 a = *(const float4*)(sC + row * 132 + ch * 8), c = *(const float4*)(sC + row * 132 + ch * 8 + 4);
        uint4 o;
        o.x = pack2(a.x * fmaxf(bflo(ga.x), 1e-20f), a.y * fmaxf(bfhi(ga.x), 1e-20f));
        o.y = pack2(a.z * fmaxf(bflo(ga.y), 1e-20f), a.w * fmaxf(bfhi(ga.y), 1e-20f));
        o.z = pack2(c.x * fmaxf(bflo(ga.z), 1e-20f), c.y * fmaxf(bfhi(ga.z), 1e-20f));
        o.w = pack2(c.z * fmaxf(bflo(ga.w), 1e-20f), c.w * fmaxf(bfhi(ga.w), 1e-20f));
        *(uint4*)(p.MIXED + ((long)mt * 128 + row) * 1024 + nt * 128 + ch * 8) = o;
      }
      __syncthreads();
    }
  }
}

DI void ph_outproj(const P& p, int l, char* smem, int bid, int nb, const Xcd xc) {
  const int tid = opaque_tid();
  float* sC = (float*)smem;
  XCD_TILE_LOOP(64, 4, mt2, nt2) {
    f32x16 acc[4][2];
    zero_acc<4>(acc);
    gemm_main<4>(p.MIXED + (long)mt2 * 256 * 1024, 1024, p.WOUT + ((long)l * 1024 + nt2 * 256) * 1024, 1024, 1024, acc, smem, tid, 0);
#pragma unroll 1
    for (int q = 0; q < 4; q++) {
      const int mh = q >> 1, nh = q & 1, mt = mt2 * 2 + mh, nt = nt2 * 2 + nh;
      stage_q(acc, sC, tid, mh, nh);
#pragma unroll 1
      for (int unit = opaque_tid(); unit < 2048; unit += NTHR) {
        int row = unit >> 4, ch = unit & 15;
        long gi = ((long)mt * 128 + row) * 1024 + nt * 128 + ch * 8;
        float4 a = *(const float4*)(sC + row * 132 + ch * 8), c = *(const float4*)(sC + row * 132 + ch * 8 + 4);
        float4 xa = *(const float4*)(p.XS + gi), xc4 = *(const float4*)(p.XS + gi + 4);
        a.x += ALPHA * xa.x; a.y += ALPHA * xa.y; a.z += ALPHA * xa.z; a.w += ALPHA * xa.w;
        c.x += ALPHA * xc4.x; c.y += ALPHA * xc4.y; c.z += ALPHA * xc4.z; c.w += ALPHA * xc4.w;
        *(float4*)(p.out + gi) = a; *(float4*)(p.out + gi + 4) = c;
      }
      __syncthreads();
    }
  }
}

DI void ph_ln1(const P& p, int l, int bid, int nb) {
  const int tid = opaque_vtid(), lane = tid & 63, wave = tid >> 6;
  for (int row = bid * 4 + wave; row < T; row += nb * 4) {
    const float* src = p.out + (long)row * 1024;
    float v[16];
#pragma unroll
    for (int c = 0; c < 4; c++) { float4 t = *(const float4*)(src + (lane + 64 * c) * 4); v[c * 4] = t.x; v[c * 4 + 1] = t.y; v[c * 4 + 2] = t.z; v[c * 4 + 3] = t.w; }
    ln16_write(v, p.ln1g + l * 1024, p.ln1b + l * 1024, p.XS + (long)row * 1024, p.XB + (long)row * 1024, lane);
  }
}

DI void ph_peerq(const P& p, int l, char* smem, int bid, int nb, const Xcd xc) {
  const int tid = opaque_tid();
  float* sC = (float*)smem;
  XCD_TILE_LOOP(64, 8, mt2, nt2) {
    f32x16 acc[4][2];
    zero_acc<4>(acc);
    gemm_main<4>(p.XB + (long)mt2 * 256 * 1024, 1024, p.WQ + ((long)l * 2048 + nt2 * 256) * 1024, 1024, 1024, acc, smem, tid, 0);
#pragma unroll 1
    for (int q = 0; q < 4; q++) {
      const int mh = q >> 1, nh = q & 1, mt = mt2 * 2 + mh, nt = nt2 * 2 + nh;
      stage_q(acc, sC, tid, mh, nh);
#pragma unroll 1
      for (int unit = opaque_tid(); unit < 2048; unit += NTHR) {
        int row = unit >> 4, ch = unit & 15;
        float4 a = *(const float4*)(sC + row * 132 + ch * 8), c = *(const float4*)(sC + row * 132 + ch * 8 + 4);
        uint4 o; o.x = pack2(a.x, a.y); o.y = pack2(a.z, a.w); o.z = pack2(c.x, c.y); o.w = pack2(c.z, c.w);
        *(uint4*)(p.QP + ((long)mt * 128 + row) * 2048 + nt * 128 + ch * 8) = o;
      }
      __syncthreads();
    }
  }
}

DI int okey(float v) { int b = __float_as_int(v); return b ^ ((b >> 31) & 0x7fffffff); }
DI float okey_val(int k) { return __int_as_float(k ^ ((k >> 31) & 0x7fffffff)); }
DI int med3i(int a, int b, int c) { int r; asm("v_med3_i32 %0, %1, %2, %3" : "=v"(r) : "v"(a), "v"(b), "v"(c)); return r; }
DI void ins16(int (&L)[16], int x) {
#pragma unroll
  for (int i = 15; i > 0; i--) L[i] = med3i(L[i - 1], L[i], x);
  L[0] = max(L[0], x);
}

DI void peer_finish_token(const P& p, int l, bool last, const long tok, f32x2 (&acc2)[8], float csum, const int lane) {
      float acc[16];
#pragma unroll
      for (int i = 0; i < 8; i++) { acc[2 * i] = acc2[i].x; acc[2 * i + 1] = acc2[i].y; }
      csum *= 128.f;
      const float* xs = p.XS + tok * 1024 + lane * 16;
      float y[16];
#pragma unroll
      for (int c = 0; c < 4; c++) {
        float4 a = *(const float4*)(xs + c * 4);
        y[c * 4 + 0] = ALPHA * a.x + acc[c * 4 + 0] - csum; y[c * 4 + 1] = ALPHA * a.y + acc[c * 4 + 1] - csum;
        y[c * 4 + 2] = ALPHA * a.z + acc[c * 4 + 2] - csum; y[c * 4 + 3] = ALPHA * a.w + acc[c * 4 + 3] - csum;
      }
      float s = 0.f;
#pragma unroll
      for (int i = 0; i < 16; i++) s += y[i];
      float mu = wave_sum(s) * (1.f / 1024.f);
      float q = 0.f;
#pragma unroll
      for (int i = 0; i < 16; i++) { float dd = y[i] - mu; q += dd * dd; }
      float rstd = rsqrtf(wave_sum(q) * (1.f / 1024.f) + 1e-5f);
      const float* g = p.ln2g + l * 1024;
      const float* bt = p.ln2b + l * 1024;
      float* dstf;
      if (last) {
        int b = (int)(tok >> 13), u = (int)(tok & 8191);
        int sact = (u & 127) * 64 + (u >> 7);
        dstf = p.out + ((long)b * 8192 + sact) * 1024;
      } else dstf = p.XS + tok * 1024;
      {
        const int e0 = lane * 16;
        float o[16];
#pragma unroll
        for (int c = 0; c < 4; c++) {
          float4 g0 = *(const float4*)(g + e0 + c * 4), b0 = *(const float4*)(bt + e0 + c * 4);
          o[c * 4 + 0] = (y[c * 4 + 0] - mu) * rstd * g0.x + b0.x; o[c * 4 + 1] = (y[c * 4 + 1] - mu) * rstd * g0.y + b0.y;
          o[c * 4 + 2] = (y[c * 4 + 2] - mu) * rstd * g0.z + b0.z; o[c * 4 + 3] = (y[c * 4 + 3] - mu) * rstd * g0.w + b0.w;
          *(float4*)(dstf + e0 + c * 4) = make_float4(o[c * 4], o[c * 4 + 1], o[c * 4 + 2], o[c * 4 + 3]);
        }
        if (!last) {
          uint4 pk; pk.x = pack2(o[0], o[1]); pk.y = pack2(o[2], o[3]); pk.z = pack2(o[4], o[5]); pk.w = pack2(o[6], o[7]);
          *(uint4*)(p.XB + tok * 1024 + e0) = pk;
          pk.x = pack2(o[8], o[9]); pk.y = pack2(o[10], o[11]); pk.z = pack2(o[12], o[13]); pk.w = pack2(o[14], o[15]);
          *(uint4*)(p.XB + tok * 1024 + e0 + 8) = pk;
        }
      }
}

DI void ph_peer(const P& p, int l, char* smem, int bid, int nb, bool last) {
  const int tid = opaque_vtid(), lane = tid & 63, wave = tid >> 6;
  const int tl = lane & 31, hf = lane >> 5;
  int* sel_e = (int*)smem;
  float* sel_w = (float*)(smem + 16384);
  unsigned char* sidx = (unsigned char*)(smem + 32768);
  float* scoef = (float*)(smem + 32768 + 4096);
  const u16* SKl = p.SK + (long)l * 8 * 2 * 128 * 128;
  const unsigned char* Ul = p.U8 + (long)l * 16384 * 1024;
  const unsigned char* Vl = p.V8 + (long)l * 16384 * 1024;
  const float* SUl = p.SU + l * 16384;
  const float* SVl = p.SV + l * 16384;
  for (int tk = bid; tk < T / 32; tk += nb) {
    const int t0 = tk * 32;
    const int tidr_ = opaque_vtid();
    const int lane = tidr_ & 63, wave = tidr_ >> 6, tl = lane & 31, hf = lane >> 5;
    __syncthreads();
    for (int hi = 0; hi < 2; hi++) {
      const int hh = wave + 4 * hi;
      int L1[16], L2[16];
#pragma unroll
      for (int half = 0; half < 2; half++) {
        f32x16 acc[4];
#pragma unroll
        for (int mt = 0; mt < 4; mt++)
#pragma unroll
          for (int r = 0; r < 16; r++) acc[mt][r] = 0.f;
        const u16* qrow = p.QP + (long)(t0 + tl) * 2048 + hh * 256 + half * 128 + hf * 8;
        const u16* krow = SKl + ((long)(hh * 2 + half) * 128 + tl) * 128 + hf * 8;
#pragma unroll
        for (int kd = 0; kd < 8; kd++) {
          bf16x8 bq = *(const bf16x8*)(qrow + kd * 16);
#pragma unroll
          for (int mt = 0; mt < 4; mt++) {
            bf16x8 ak = *(const bf16x8*)(krow + (long)mt * 32 * 128 + kd * 16);
            acc[mt] = MFMA(ak, bq, acc[mt]);
          }
          if (kd == 3) __builtin_amdgcn_sched_barrier(0);
        }
        int L[16];
#pragma unroll
        for (int i = 0; i < 16; i++) L[i] = (int)0x80000000;
#pragma unroll
        for (int mt = 0; mt < 4; mt++)
#pragma unroll
          for (int r = 0; r < 16; r++) {
            int key = mt * 32 + 8 * (r >> 2) + 4 * hf + (r & 3);
            int k = (okey(acc[mt][r]) & ~0x7f) | (127 - key);
            ins16(L, k);
          }
        int S[16];
#pragma unroll
        for (int i = 0; i < 16; i++) S[i] = L[i];
#pragma unroll
        for (int i = 0; i < 16; i++) { int pv = shxi<32>(S[i]); ins16(L, pv); }
        if (half == 0) {
#pragma unroll
          for (int i = 0; i < 16; i++) L1[i] = L[i];
        } else {
#pragma unroll
          for (int i = 0; i < 16; i++) L2[i] = L[i];
        }
      }
      float v1[16], v2[16];
#pragma unroll
      for (int i = 0; i < 16; i++) { v1[i] = okey_val(L1[i] & ~0x7f); v2[i] = okey_val(L2[i] & ~0x7f); }
      unsigned char* myidx = sidx + (wave * 32 + tl) * 32;
      if (hf == 0) {
#pragma unroll
        for (int i = 0; i < 16; i++) { myidx[i] = (unsigned char)(127 - (L1[i] & 0x7f)); myidx[16 + i] = (unsigned char)(127 - (L2[i] & 0x7f)); }
      }
      int C[16];
#pragma unroll
      for (int i = 0; i < 16; i++) C[i] = (int)0x80000000;
#pragma unroll
      for (int i = 0; i < 16; i++)
#pragma unroll
        for (int j = 0; j < 16; j++)
          if ((i + 1) * (j + 1) <= 16) {
            int k = (okey(v1[i] + v2[j]) & ~0xff) | (255 - (i * 16 + j));
            ins16(C, k);
          }
      float sv[16];
#pragma unroll
      for (int r = 0; r < 16; r++) sv[r] = okey_val(C[r] & ~0xff);
      float den = 0.f;
      {
        float top = sv[0];
#pragma unroll
        for (int r = 0; r < 16; r++) { sv[r] = __expf(sv[r] - top); den += sv[r]; }
      }
      float rden = 1.f / den;
#pragma unroll
      for (int r = 0; r < 16; r++) {
        if ((r >> 3) == hf) {
          int pos = 255 - (C[r] & 0xff);
          int i1 = myidx[pos >> 4], i2 = myidx[16 + (pos & 15)];
          sel_e[tl * 128 + hh * 16 + r] = i1 * 128 + i2;
          sel_w[tl * 128 + hh * 16 + r] = sv[r] * rden;
        }
      }
    }
    __syncthreads();
    int* nlo_tab = (int*)sidx;
    for (int tt = wave; tt < 32; tt += 4) {
      const int e0_ = sel_e[tt * 128 + lane], e1_ = sel_e[tt * 128 + lane + 64];
      const float w0_ = sel_w[tt * 128 + lane], w1_ = sel_w[tt * 128 + lane + 64];
      const bool lo0 = e0_ < 8192, lo1 = e1_ < 8192;
      const unsigned long long m0 = __ballot(lo0), m1 = __ballot(lo1);
      const unsigned long long lt = (1ull << lane) - 1ull;
      const int c0 = __popcll(m0), c1 = __popcll(m1), nlo = c0 + c1;
      const int p0 = lo0 ? __popcll(m0 & lt) : nlo + __popcll(~m0 & lt);
      const int p1 = lo1 ? c0 + __popcll(m1 & lt) : nlo + (64 - c0) + __popcll(~m1 & lt);
      __builtin_amdgcn_wave_barrier();
      sel_e[tt * 128 + p0] = e0_; sel_e[tt * 128 + p1] = e1_;
      sel_w[tt * 128 + p0] = w0_; sel_w[tt * 128 + p1] = w1_;
      if (lane == 0) nlo_tab[tt] = nlo;
    }
    __builtin_amdgcn_wave_barrier();
    {
    const int tidg_ = opaque_vtid();
    const int lane = tidg_ & 63, wave = tidg_ >> 6;
    const int sub = lane & 15, grp = lane >> 4;
#pragma unroll 1
    for (int upass = 0; upass < 2; upass++)
    for (int tt = wave; tt < 32; tt += 4) {
      const long tok = t0 + tt;
      const int ssp = ((nlo_tab[tt] + 8) >> 4) << 1;
      const int s_beg = upass ? ssp : 0, s_end = upass ? 16 : ssp;
      f32x2 xf[32];
      float sx = 0.f;
#pragma unroll
      for (int c = 0; c < 4; c++) {
#pragma unroll
        for (int h2 = 0; h2 < 2; h2++) {
          uint4 xr = *(const uint4*)(p.XB + tok * 1024 + (sub + 16 * c) * 16 + h2 * 8);
          f32x2* xp = xf + c * 8 + h2 * 4;
          xp[0] = f32x2{bflo(xr.x), bfhi(xr.x)}; xp[1] = f32x2{bflo(xr.y), bfhi(xr.y)};
          xp[2] = f32x2{bflo(xr.z), bfhi(xr.z)}; xp[3] = f32x2{bflo(xr.w), bfhi(xr.w)};
        }
      }
#pragma unroll
      for (int i = 0; i < 32; i++) sx += xf[i].x + xf[i].y;
      sx *= 128.f;
      float dk0 = 0.f, dk1 = 0.f;
      u32x4 bufA[8], bufB[8];
#define ISSUE_U(buf, st)                                                                 \
      _Pragma("unroll") for (int j = 0; j < 2; j++) {                                    \
        const int eidx_ = sel_e[tt * 128 + ((st) * 2 + j) * 4 + grp];                    \
        const unsigned char* ur_ = Ul + (long)eidx_ * 1024 + sub * 16;                   \
        _Pragma("unroll") for (int c = 0; c < 4; c++) buf[j * 4 + c] = *(const u32x4*)(ur_ + c * 256); \
      }
#define COMPUTE_U(buf, st)                                                               \
      _Pragma("unroll") for (int j = 0; j < 2; j++) {                                    \
        f32x2 d2 = f32x2{-sx, 0.f};                                                      \
        _Pragma("unroll") for (int c = 0; c < 4; c++)                                    \
          _Pragma("unroll") for (int w = 0; w < 4; w++) {                                \
            const unsigned q = buf[j * 4 + c][w];                                        \
            d2 += f32x2{(float)(q & 0xffu), (float)((q >> 8) & 0xffu)} * xf[c * 8 + w * 2];      \
            d2 += f32x2{(float)((q >> 16) & 0xffu), (float)(q >> 24)} * xf[c * 8 + w * 2 + 1];   \
          }                                                                              \
        float d = d2.x + d2.y;                                                           \
        d += shx<1>(d); d += shx<2>(d); d += shx<4>(d); d += shx<8>(d); \
        const int it_ = (st) * 2 + j;                                                    \
        if (sub == (it_ & 15)) { if (it_ < 16) dk0 = d; else dk1 = d; }                  \
        __builtin_amdgcn_sched_barrier(0);                                               \
      }
      if (s_beg < s_end) { ISSUE_U(bufA, s_beg) }
      for (int st = s_beg; st < s_end; st += 2) {
        ISSUE_U(bufB, st + 1)
        COMPUTE_U(bufA, st)
        if (st + 2 < s_end) { ISSUE_U(bufA, st + 2) }
        COMPUTE_U(bufB, st + 1)
      }
      {
        const int e0 = sub * 4 + grp, e1 = (16 + sub) * 4 + grp;
        const bool in0 = (sub >= 2 * s_beg) && (sub < 2 * s_end), in1 = (16 + sub >= 2 * s_beg) && (16 + sub < 2 * s_end);
        const int x0 = sel_e[tt * 128 + e0], x1 = sel_e[tt * 128 + e1];
        float d0 = dk0 * SUl[x0], d1 = dk1 * SUl[x1];
        float a0 = 0.5f * d0 * (1.f + erff(d0 * 0.7071067811865476f));
        float a1 = 0.5f * d1 * (1.f + erff(d1 * 0.7071067811865476f));
        if (in0) sel_w[tt * 128 + e0] = a0 * sel_w[tt * 128 + e0] * SVl[x0];
        if (in1) sel_w[tt * 128 + e1] = a1 * sel_w[tt * 128 + e1] * SVl[x1];
      }
    }
#pragma unroll 1
    for (int hsel = 0; hsel < 2; hsel++) {
      f32x2 accT[4][8];
      float csumT[4];
#pragma unroll
      for (int ti = 0; ti < 4; ti++) {
        csumT[ti] = 0.f;
#pragma unroll
        for (int i = 0; i < 8; i++) accT[ti][i] = f32x2{0.f, 0.f};
      }
#define ISSUE_V(buf, tt_, st)                                                            \
      _Pragma("unroll") for (int j = 0; j < 8; j++) {                                    \
        const int eidx_ = __builtin_amdgcn_readfirstlane(sel_e[(tt_) * 128 + (st) * 8 + j]); \
        buf[j] = *(const u32x4*)(Vl + (long)eidx_ * 1024 + (unsigned)(lane * 16));       \
      }
#define COMPUTE_V(buf, ti, tt_, st)                                                      \
      _Pragma("unroll") for (int j = 0; j < 8; j++) {                                    \
        const float c_ = sel_w[(tt_) * 128 + (st) * 8 + j];                              \
        csumT[ti] += c_;                                                                 \
        const f32x2 c2 = f32x2{c_, c_};                                                  \
        _Pragma("unroll") for (int w = 0; w < 4; w++) {                                  \
          const unsigned q = buf[j][w];                                                  \
          accT[ti][w * 2] += c2 * f32x2{(float)(q & 0xffu), (float)((q >> 8) & 0xffu)};  \
          accT[ti][w * 2 + 1] += c2 * f32x2{(float)((q >> 16) & 0xffu), (float)(q >> 24)}; \
        }                                                                                \
        if (j & 1) __builtin_amdgcn_sched_barrier(0);                                    \
      }
#pragma unroll 1
      for (int vpass = 0; vpass < 2; vpass++) {
#pragma unroll
        for (int ti = 0; ti < 4; ti++) {
          const int tt = wave + 4 * (hsel * 4 + ti);
          const int ssp = ((nlo_tab[tt] + 8) >> 4) << 1;
          const int c_beg = vpass ? ssp : 0, c_end = vpass ? 16 : ssp;
          u32x4 bufA[8], bufB[8];
          if (c_beg < c_end) { ISSUE_V(bufA, tt, c_beg) }
#pragma unroll 1
          for (int st = c_beg; st < c_end; st += 2) {
            ISSUE_V(bufB, tt, st + 1)
            COMPUTE_V(bufA, ti, tt, st)
            if (st + 2 < c_end) { ISSUE_V(bufA, tt, st + 2) }
            COMPUTE_V(bufB, ti, tt, st + 1)
          }
        }
      }
      peer_finish_token(p, l, last, t0 + wave + 4 * (hsel * 4 + 0), accT[0], csumT[0], lane);
      peer_finish_token(p, l, last, t0 + wave + 4 * (hsel * 4 + 1), accT[1], csumT[1], lane);
      peer_finish_token(p, l, last, t0 + wave + 4 * (hsel * 4 + 2), accT[2], csumT[2], lane);
      peer_finish_token(p, l, last, t0 + wave + 4 * (hsel * 4 + 3), accT[3], csumT[3], lane);
    }
    }
  }
}


#define XB_TMO      128
#define XB_XCNT(j)  (256  + 64 * (j))
#define XB_XSUB(j)  (1280 + 64 * (j))
#define XB_XGEN(j)  (2304 + 64 * (j))
#define XB_TOP      3328
#define XB_TOPGEN   3392
#define XB_CENSUS   3456
#define XB_FFTA     3480
#define XCD_BAR_WORDS 3488
#define XB_SPIN_CAP (1u << 22)
DI unsigned xb_ld(unsigned* p) { return __hip_atomic_load(p, __ATOMIC_RELAXED, __HIP_MEMORY_SCOPE_AGENT); }
DI unsigned xb_add(unsigned* p, unsigned v) { return __hip_atomic_fetch_add(p, v, __ATOMIC_RELAXED, __HIP_MEMORY_SCOPE_AGENT); }
DI unsigned xb_xcc_id() { return (unsigned)__builtin_amdgcn_s_getreg((3 << 11) | 20) & 0xFu; }
#define XB_SPIN(cond, bar) do { unsigned _sp = 0; while (cond) { __builtin_amdgcn_s_sleep(1); \
    if ((++_sp & 255u) == 0u) { if (xb_ld(&(bar)[XB_TMO])) break; if (_sp > XB_SPIN_CAP) { atomicAdd(&(bar)[XB_TMO], 1u); break; } } } } while (0)
struct XcdBarrier { unsigned* bar; unsigned x; volatile LAS unsigned* st; };
DI volatile LAS unsigned* xb_state() { __shared__ uint4 xb_words_; return (volatile LAS unsigned*)&xb_words_; }
DI XcdBarrier xcd_barrier_post(unsigned* bar, volatile LAS unsigned* st) {
  XcdBarrier b; b.bar = bar; b.x = xb_xcc_id(); b.st = st;
  if (threadIdx.x == 0) (void)xb_add(&bar[XB_XCNT(b.x)], 1u);
  return b;
}
DI void xcd_barrier_complete(unsigned* bar, unsigned x, unsigned& nloc, unsigned& nx) {
  const unsigned G = gridDim.x;
  unsigned sum, cnt, mine, sp = 0u;
  for (;;) {
    sum = 0u; cnt = 0u; mine = 0u;
#pragma unroll
    for (unsigned j = 0; j < 16; ++j) { const unsigned c = xb_ld(&bar[XB_XCNT(j)]); sum += c; cnt += (c > 0u) ? 1u : 0u; mine = (j == x) ? c : mine; }
    if (sum == G) break;
    __builtin_amdgcn_s_sleep(1);
    if ((++sp & 255u) == 0u) { if (xb_ld(&bar[XB_TMO])) break; if (sp > XB_SPIN_CAP) { atomicAdd(&bar[XB_TMO], 1u); break; } }
  }
  nloc = mine > 0u ? mine : 1u; nx = cnt > 0u ? cnt : 1u;
}
DI void xcd_barrier(unsigned* bar_, volatile LAS unsigned* st_) {
  XcdBarrier b; b.bar = bar_; b.st = st_; b.x = xb_xcc_id();
  asm volatile("s_waitcnt vmcnt(0)" ::: "memory");
  __syncthreads();
  if (opaque_tid() == 0) {
    unsigned* bar = b.bar;
    __builtin_amdgcn_s_waitcnt(0);
    unsigned nloc = b.st[0], nx = b.st[1];
    if (nloc == 0u) { xcd_barrier_complete(bar, b.x, nloc, nx); b.st[0] = nloc; b.st[1] = nx; }
    const unsigned old = xb_add(&bar[XB_XSUB(b.x)], 1u);
    const unsigned gen = old / nloc;
    if (old + 1u == (gen + 1u) * nloc) {
      __builtin_amdgcn_fence(__ATOMIC_RELEASE, "agent");
      asm volatile("s_waitcnt vmcnt(0)" ::: "memory");
      const unsigned og = xb_add(&bar[XB_TOP], 1u);
      const unsigned tg = og / nx;
      if (og + 1u == (tg + 1u) * nx) xb_add(&bar[XB_TOPGEN], 1u);
      else XB_SPIN(xb_ld(&bar[XB_TOPGEN]) == tg, bar);
      __builtin_amdgcn_fence(__ATOMIC_ACQUIRE, "agent");
      xb_add(&bar[XB_XGEN(b.x)], 1u);
      asm volatile("s_waitcnt vmcnt(0)" ::: "memory");
    } else {
      XB_SPIN(xb_ld(&bar[XB_XGEN(b.x)]) == gen, bar);
      __builtin_amdgcn_fence(__ATOMIC_ACQUIRE, "agent");
      asm volatile("s_waitcnt vmcnt(0)" ::: "memory");
    }
  }
  __syncthreads();
}

#ifndef REP
#define REP -1
#endif
#define BAR() xcd_barrier(p.BAR, xb_state())
#define RUNPH(k, call) do { call; if (REP == (k)) { BAR(); call; } } while (0)
__global__ void __launch_bounds__(NTHR, 2) mega_kernel(P p) {
  extern __shared__ __attribute__((aligned(1024))) char smem[];
  __shared__ int xc_sh[2];
  const int bid = blockIdx.x, nb = gridDim.x;
  if (threadIdx.x == 0) { volatile LAS unsigned* st = xb_state(); st[0] = 0u; st[1] = 0u; st[2] = 0u; st[3] = 0u; }
  if ((threadIdx.x & 63) == 0) wmap()[hw_slot()] = (int)(threadIdx.x >> 6);
  __syncthreads();
  (void)xcd_barrier_post(p.BAR, xb_state());
  if (threadIdx.x == 0) { const unsigned x = xb_xcc_id() & 7u; xc_sh[0] = (int)x; xc_sh[1] = (int)xb_add(&p.BAR[XB_CENSUS + x], 1u); }
  __syncthreads();
  const int vb = __builtin_amdgcn_readfirstlane((int)threadIdx.x >> 8);
  const int vbid = bid * 2 + vb, vnb = nb * 2;
  char* vsmem = smem + vb * VSMEM;
  RUNPH(0, ph_prep(p, vsmem, vbid, vnb));
  BAR();
  Xcd xc;
  xc.id = __builtin_amdgcn_readfirstlane(xc_sh[0]); xc.slot = __builtin_amdgcn_readfirstlane(xc_sh[1]);
  xc.n = __builtin_amdgcn_readfirstlane((int)xb_ld(&p.BAR[XB_CENSUS + xc.id]));
#pragma unroll 1
  for (int l = 0; l < 2; l++) {
    RUNPH(1, ph_inproj(p, l, smem, bid, nb, xc));
    BAR();
    ph_fftA(p, smem, bid, nb);
    {
      asm volatile("s_waitcnt vmcnt(0)" ::: "memory");
      __syncthreads();
      unsigned ndone = 0;
      for (int t2 = bid; t2 < 130; t2 += nb) ndone++;
      if (ndone && opaque_tid() == 0) {
        __builtin_amdgcn_fence(__ATOMIC_RELEASE, "agent");
        asm volatile("s_waitcnt vmcnt(0)" ::: "memory");
        (void)xb_add(&p.BAR[XB_FFTA], ndone);
      }
    }
    RUNPH(2, ph_attn(p, l, vsmem, xc, vb));
    {
      asm volatile("s_waitcnt vmcnt(0)" ::: "memory");
      __syncthreads();
      if (opaque_tid() == 0) {
        const unsigned want = 130u * (unsigned)(l + 1);
        XB_SPIN(xb_ld(&p.BAR[XB_FFTA]) < want, p.BAR);
        __builtin_amdgcn_fence(__ATOMIC_ACQUIRE, "agent");
        asm volatile("s_waitcnt vmcnt(0)" ::: "memory");
      }
      __syncthreads();
    }
    ph_fftC(p, smem, bid, nb);
    BAR();
    RUNPH(4, ph_branch(p, l, smem, bid, nb, xc));
    BAR();
    RUNPH(5, ph_outproj(p, l, smem, bid, nb, xc));
    BAR();
    RUNPH(6, ph_ln1(p, l, vbid, vnb));
    BAR();
    RUNPH(7, ph_peerq(p, l, smem, bid, nb, xc));
    BAR();
    if (REP == 8) { ph_peer(p, l, vsmem, vbid, vnb, true); BAR(); }
    ph_peer(p, l, vsmem, vbid, vnb, l == 1);
    if (l == 0) BAR();
  }
}

extern "C" void kernel_launch(void* const* d_in, const int* in_sizes, int n_in, void* d_out, int out_size,
                              void* d_ws, size_t ws_size, hipStream_t stream) {
  P p{};
  p.x = (const float*)d_in[0]; p.ln0g = (const float*)d_in[1]; p.ln0b = (const float*)d_in[2];
  p.w_in = (const float*)d_in[3]; p.b_gate = (const float*)d_in[4]; p.qng = (const float*)d_in[5]; p.kng = (const float*)d_in[6];
  p.w_bf = (const float*)d_in[7]; p.w_ba = (const float*)d_in[8]; p.w_out = (const float*)d_in[9];
  p.ln1g = (const float*)d_in[10]; p.ln1b = (const float*)d_in[11]; p.w_q = (const float*)d_in[12]; p.sk = (const float*)d_in[13];
  p.pu = (const float*)d_in[14]; p.pv = (const float*)d_in[15]; p.ln2g = (const float*)d_in[16]; p.ln2b = (const float*)d_in[17];
  p.out = (float*)d_out;
  char* w = (char*)d_ws;
  size_t off = 0;
  auto take = [&](size_t bytes) { char* r = w + off; off += (bytes + 255) & ~(size_t)255; return r; };
  p.WIN = (u16*)take((size_t)2 * 3328 * 1024 * 2);
  p.WBF = (u16*)take((size_t)2 * 1024 * 512 * 2);
  p.WBA = (u16*)take((size_t)2 * 1024 * 512 * 2);
  p.WOUT = (u16*)take((size_t)2 * 1024 * 1024 * 2);
  p.WQ = (u16*)take((size_t)2 * 2048 * 1024 * 2);
  p.SK = (u16*)take((size_t)2 * 8 * 2 * 128 * 128 * 2);
  p.U8 = (unsigned char*)take((size_t)2 * 16384 * 1024);
  p.V8 = (unsigned char*)take((size_t)2 * 16384 * 1024);
  p.SU = (float*)take((size_t)2 * 16384 * 4);
  p.SV = (float*)take((size_t)2 * 16384 * 4);
  p.D256 = (u16*)take(256 * 256 * 2);
  p.C64 = (u16*)take(64 * 128 * 2);
  p.TW = (float2*)take(128 * 64 * 8);
  p.ROPE = (float2*)take(128 * 16 * 8);
  p.XS = (float*)take((size_t)T * 1024 * 4);
  p.XB = (u16*)take((size_t)T * 1024 * 2);
  p.ZT = (u16*)take((size_t)33280 * 256 * 2);
  p.GP = (u16*)take((size_t)66560 * 128 * 2);
  p.Y = (u16*)take((size_t)T * 512 * 2);
  p.Q = (u16*)take((size_t)T * 512 * 2);
  p.K = (u16*)take((size_t)T * 128 * 2);
  p.VT = (u16*)take((size_t)T * 128 * 2);
  p.AO = (u16*)take((size_t)T * 512 * 2);
  p.GATES = (u16*)take((size_t)T * 2048 * 2);
  p.QP = p.GATES;
  p.MIXED = (u16*)take((size_t)T * 1024 * 2);
  p.BAR = (unsigned*)take(XCD_BAR_WORDS * 4);
  if (off > ws_size) { fprintf(stderr, "workspace too small: need %zu have %zu\n", off, ws_size); return; }

  static int grid_blocks = 0;
  if (!grid_blocks) {
    int dev = 0, cus = 0, per_cu = 0;
    (void)hipGetDevice(&dev);
    (void)hipDeviceGetAttribute(&cus, hipDeviceAttributeMultiprocessorCount, dev);
    (void)hipFuncSetAttribute((const void*)mega_kernel, hipFuncAttributeMaxDynamicSharedMemorySize, SMEM_BYTES);
    (void)hipOccupancyMaxActiveBlocksPerMultiprocessor(&per_cu, mega_kernel, NTHR, SMEM_BYTES);
    if (per_cu < 1) per_cu = 1;
    grid_blocks = cus;
  }
  (void)hipMemsetAsync(p.BAR, 0, XCD_BAR_WORDS * 4, stream);
  void* args[] = {&p};
  hipError_t e = hipLaunchCooperativeKernel((void*)mega_kernel, dim3(grid_blocks), dim3(NTHR), args, SMEM_BYTES, stream);
  if (e != hipSuccess) fprintf(stderr, "cooperative launch failed: %s (grid %d)\n", hipGetErrorString(e), grid_blocks);
}
```

```cpp
#include <hip/hip_runtime.h>
#include <hip/hip_cooperative_groups.h>
#include <cstdio>
namespace cg = cooperative_groups;


typedef unsigned short u16;
using bf16x8 = __attribute__((ext_vector_type(8))) short;
using s16x4  = __attribute__((ext_vector_type(4))) short;
using f32x16 = __attribute__((ext_vector_type(16))) float;
using u32x4  = __attribute__((ext_vector_type(4))) unsigned;
using f32x2  = __attribute__((ext_vector_type(2))) float;
using f32x4n = __attribute__((ext_vector_type(4))) float;
#define DI __device__ __forceinline__
#define MFMA(a, b, c) __builtin_amdgcn_mfma_f32_32x32x16_bf16((a), (b), (c), 0, 0, 0)

constexpr int T = 16384;
constexpr float ALPHA = 1.4142135623730951f;
constexpr int NTHR = 512;
constexpr int VSMEM = 73728;
constexpr int SMEM_BYTES = 2 * VSMEM;

struct P {
  const float *x, *ln0g, *ln0b, *w_in, *b_gate, *qng, *kng, *w_bf, *w_ba, *w_out, *ln1g, *ln1b, *w_q, *sk, *pu, *pv, *ln2g, *ln2b;
  float* out;
  u16 *WIN, *WBF, *WBA, *WOUT, *WQ, *SK, *D256, *C64;
  float2 *TW, *ROPE;
  float* XS;
  u16 *XB, *ZT, *GP, *Y, *Q, *K, *VT, *AO, *GATES, *MIXED, *QP;
  unsigned* BAR;
  unsigned char *U8, *V8;
  float *SU, *SV;
};

DI u16 f2bf(float f) { __bf16 h = (__bf16)f; return __builtin_bit_cast(u16, h); }
DI float bf2f(u16 h) { return __uint_as_float(((unsigned)h) << 16); }
DI unsigned pack2(float a, float b) { return (unsigned)f2bf(a) | ((unsigned)f2bf(b) << 16); }
DI float bflo(unsigned u) { return __uint_as_float(u << 16); }
DI float bfhi(unsigned u) { return __uint_as_float(u & 0xffff0000u); }
#define LAS __attribute__((address_space(3)))
DI int hw_slot() { return __builtin_amdgcn_s_getreg((5 << 11) | 4) & 63; }
DI volatile LAS int* wmap() { __shared__ int wm_[64]; return (volatile LAS int*)wm_; }
DI int lane_id() { int l; asm volatile("v_mbcnt_lo_u32_b32 %0, -1, 0\n\tv_mbcnt_hi_u32_b32 %0, -1, %0" : "=&v"(l)); return l; }
DI int opaque_tid() { int w = wmap()[hw_slot()]; int t = (w << 6) | lane_id(); asm volatile("" : "+v"(t)); return t; }
DI int opaque_vtid() { return opaque_tid() & 255; }
template <int M> DI int shxi(int v) {
  if constexpr (M < 32) return __builtin_amdgcn_ds_swizzle(v, (M << 10) | 0x1f);
  else { int a = (lane_id() ^ 32) << 2; asm volatile("" : "+v"(a)); return __builtin_amdgcn_ds_bpermute(a, v); }
}
template <int M> DI float shx(float v) { return __int_as_float(shxi<M>(__float_as_int(v))); }
#define NTS4(ptr, v) __builtin_nontemporal_store(u32x4{(v).x, (v).y, (v).z, (v).w}, (u32x4*)(ptr))
#define NTSF4(ptr, v) __builtin_nontemporal_store(f32x4n{(v).x, (v).y, (v).z, (v).w}, (f32x4n*)(ptr))
DI float wave_sum(float v) {
  v += shx<32>(v); v += shx<16>(v); v += shx<8>(v); v += shx<4>(v); v += shx<2>(v); v += shx<1>(v);
  return v;
}

template <int MT>
DI void gemm_main(const u16* __restrict__ A, long lda, const u16* __restrict__ B, long ldb, int K,
                  f32x16 (&acc)[MT][2], char* smem, const int  , const int rot = 0) {
  constexpr int STAGE = (64 * MT + 256) * 72;
  u16* s0 = (u16*)smem;
  const int tid = opaque_tid();
  const int lane = tid & 63, wave = tid >> 6;
  const int wm = wave >> 2, wn = wave & 3;
  const int lr = tid >> 3, lc = (tid & 7) * 8;
  const u16* Ap = A + (long)lr * lda + lc;
  const u16* Bp = B + (long)lr * ldb + lc;
  u32x4 ra[MT], rb[4];
  const int nk = K >> 6;
#define G_LOAD(kt)                                                                                      \
  _Pragma("unroll") for (int c = 0; c < MT; c++) ra[c] = *(const u32x4*)(Ap + (long)(64 * c) * lda + (((kt) + rot) & (nk - 1)) * 64); \
  _Pragma("unroll") for (int c = 0; c < 4; c++) rb[c] = *(const u32x4*)(Bp + (long)(64 * c) * ldb + (((kt) + rot) & (nk - 1)) * 64);
#define G_STORE(st)                                                                                     \
  { u16* sA_ = s0 + (st) * STAGE; u16* sB_ = sA_ + 64 * MT * 72;                                        \
    _Pragma("unroll") for (int c = 0; c < MT; c++) *(u32x4*)(sA_ + (lr + 64 * c) * 72 + lc) = ra[c];    \
    _Pragma("unroll") for (int c = 0; c < 4; c++) *(u32x4*)(sB_ + (lr + 64 * c) * 72 + lc) = rb[c]; }
#define G_COMPUTE(st)                                                                                   \
  { const u16* sA_ = s0 + (st) * STAGE; const u16* sB_ = sA_ + 64 * MT * 72;                            \
    _Pragma("unroll") for (int kk = 0; kk < 4; kk++) {                                                  \
      bf16x8 af[MT], bfr[2];                                                                            \
      _Pragma("unroll") for (int i = 0; i < MT; i++) af[i] = *(const bf16x8*)(sA_ + (wm * 32 * MT + i * 32 + (lane & 31)) * 72 + kk * 16 + (lane >> 5) * 8); \
      _Pragma("unroll") for (int j = 0; j < 2; j++) bfr[j] = *(const bf16x8*)(sB_ + (wn * 64 + j * 32 + (lane & 31)) * 72 + kk * 16 + (lane >> 5) * 8);     \
      _Pragma("unroll") for (int i = 0; i < MT; i++)                                                    \
        _Pragma("unroll") for (int j = 0; j < 2; j++) acc[i][j] = MFMA(af[i], bfr[j], acc[i][j]);       \
      if (MT > 2) __builtin_amdgcn_sched_barrier(0);                                                    \
    } }
  G_LOAD(0)
  __syncthreads();
  G_STORE(0)
  G_LOAD((1 < nk ? 1 : 0))
  __syncthreads();
  const bool late = __builtin_amdgcn_readfirstlane(wave) >= 4;
  for (int t = 0; t < nk; t++) {
    if (!late) {
      if (t + 1 < nk) { G_STORE((t + 1) & 1) }
      if (t + 2 < nk) { G_LOAD(t + 2) }
    }
    __builtin_amdgcn_s_setprio(1);
    G_COMPUTE(t & 1)
    __builtin_amdgcn_s_setprio(0);
    if (late) {
      if (t + 1 < nk) { G_STORE((t + 1) & 1) }
      if (t + 2 < nk) { G_LOAD(t + 2) }
    }
    __syncthreads();
  }
#undef G_LOAD
#undef G_STORE
#undef G_COMPUTE
}

struct Xcd { int id, slot, n; };
#define XCD_TILE_LOOP(MTOT, NTOT, mt, nt)                                             \
  for (int j_ = xc.slot, mt, nt; j_ < ((MTOT) / 8) * (NTOT) && (mt = xc.id * ((MTOT) / 8) + j_ % ((MTOT) / 8), nt = j_ / ((MTOT) / 8), true); j_ += xc.n)

template <int MT>
DI void zero_acc(f32x16 (&acc)[MT][2]) {
#pragma unroll
  for (int i = 0; i < MT; i++)
#pragma unroll
    for (int j = 0; j < 2; j++)
#pragma unroll
      for (int r = 0; r < 16; r++) acc[i][j][r] = 0.f;
}

DI void stage_q(f32x16 (&acc)[4][2], float* sC, const int tid, const int mh, const int nh) {
  const int lane = tid & 63, wave = tid >> 6, wm = wave >> 2, wn = wave & 3;
  if (wm == mh && (wn >> 1) == nh) {
#pragma unroll
    for (int i = 0; i < 4; i++)
#pragma unroll
      for (int j = 0; j < 2; j++)
#pragma unroll
        for (int r = 0; r < 16; r++) {
          int row = i * 32 + 8 * (r >> 2) + 4 * (lane >> 5) + (r & 3);
          int col = (wn & 1) * 64 + j * 32 + (lane & 31);
          sC[row * 132 + col] = acc[i][j][r];
        }
  }
  __syncthreads();
}
DI void stage_q_tr(f32x16 (&acc)[4][2], float* sC, const int tid, const int mh, const int nh) {
  const int lane = tid & 63, wave = tid >> 6, wm = wave >> 2, wn = wave & 3;
  if (wm == mh && (wn >> 1) == nh) {
#pragma unroll
    for (int i = 0; i < 4; i++)
#pragma unroll
      for (int j = 0; j < 2; j++)
#pragma unroll
        for (int rq = 0; rq < 4; rq++) {
          int row = i * 32 + 8 * rq + 4 * (lane >> 5);
          int col = (wn & 1) * 64 + j * 32 + (lane & 31);
          float4 v = make_float4(acc[i][j][rq * 4], acc[i][j][rq * 4 + 1], acc[i][j][rq * 4 + 2], acc[i][j][rq * 4 + 3]);
          *(float4*)(sC + col * 132 + row) = v;
        }
  }
  __syncthreads();
}
DI void unstage_q(f32x16 (&acc)[4][2], const float* sC, const int tid, const int mh, const int nh) {
  const int lane = tid & 63, wave = tid >> 6, wm = wave >> 2, wn = wave & 3;
  if (wm == mh && (wn >> 1) == nh) {
#pragma unroll
    for (int i = 0; i < 4; i++)
#pragma unroll
      for (int j = 0; j < 2; j++)
#pragma unroll
        for (int r = 0; r < 16; r++) {
          int row = i * 32 + 8 * (r >> 2) + 4 * (lane >> 5) + (r & 3);
          int col = (wn & 1) * 64 + j * 32 + (lane & 31);
          acc[i][j][r] = sC[row * 132 + col];
        }
  }
  __syncthreads();
}
DI void stage_h1(f32x16 (&acc)[1][2], float* sC, const int tid, const int nh) {
  const int lane = tid & 63, wave = tid >> 6, wm = wave >> 2, wn = wave & 3;
  if ((wn >> 1) == nh) {
#pragma unroll
    for (int j = 0; j < 2; j++)
#pragma unroll
      for (int r = 0; r < 16; r++) {
        int row = wm * 32 + 8 * (r >> 2) + 4 * (lane >> 5) + (r & 3);
        int col = (wn & 1) * 64 + j * 32 + (lane & 31);
        sC[row * 132 + col] = acc[0][j][r];
      }
  }
  __syncthreads();
}

DI void ln16_write(float (&v)[16], const float* g, const float* bt, float* dstf, u16* dstb, int lane) {
  float s = 0.f;
#pragma unroll
  for (int i = 0; i < 16; i++) s += v[i];
  float mu = wave_sum(s) * (1.f / 1024.f);
  float q = 0.f;
#pragma unroll
  for (int i = 0; i < 16; i++) { float d = v[i] - mu; q += d * d; }
  float rstd = rsqrtf(wave_sum(q) * (1.f / 1024.f) + 1e-5f);
#pragma unroll
  for (int c = 0; c < 4; c++) {
    int e = (lane + 64 * c) * 4;
    float4 gg = *(const float4*)(g + e), bb = *(const float4*)(bt + e);
    float4 o;
    o.x = (v[c * 4 + 0] - mu) * rstd * gg.x + bb.x;
    o.y = (v[c * 4 + 1] - mu) * rstd * gg.y + bb.y;
    o.z = (v[c * 4 + 2] - mu) * rstd * gg.z + bb.z;
    o.w = (v[c * 4 + 3] - mu) * rstd * gg.w + bb.w;
    if (dstf) *(float4*)(dstf + e) = o;
    if (dstb) { uint2 pk; pk.x = pack2(o.x, o.y); pk.y = pack2(o.z, o.w); *(uint2*)(dstb + e) = pk; }
  }
}

DI void transpose_tile(const float* __restrict__ src, int ldsrc, u16* __restrict__ dst, int lddst, float* tile  , const int tid, const bool act) {
  __syncthreads();
#pragma unroll
  for (int i = 0; i < 4; i++) {
    int r = (tid >> 4) + 16 * i, c4 = (tid & 15) * 4;
    float4 v = *(const float4*)(src + (long)r * ldsrc + c4);
    tile[r * 65 + c4] = v.x; tile[r * 65 + c4 + 1] = v.y; tile[r * 65 + c4 + 2] = v.z; tile[r * 65 + c4 + 3] = v.w;
  }
  __syncthreads();
#pragma unroll
  for (int i = 0; i < 2; i++) {
    int unit = tid + 256 * i, n = unit >> 3, ch = unit & 7;
    uint4 o;
    o.x = pack2(tile[(ch * 8 + 0) * 65 + n], tile[(ch * 8 + 1) * 65 + n]);
    o.y = pack2(tile[(ch * 8 + 2) * 65 + n], tile[(ch * 8 + 3) * 65 + n]);
    o.z = pack2(tile[(ch * 8 + 4) * 65 + n], tile[(ch * 8 + 5) * 65 + n]);
    o.w = pack2(tile[(ch * 8 + 6) * 65 + n], tile[(ch * 8 + 7) * 65 + n]);
    if (act) *(uint4*)(dst + (long)n * lddst + ch * 8) = o;
  }
}

DI void ph_prep(const P& p, char* smem, int bid, int nb) {
  constexpr int VT = 256;
  const int tid = opaque_vtid(), lane = tid & 63, wave = tid >> 6;
  for (int row = bid * 4 + wave; row < T; row += nb * 4) {
    const float* src = p.x + (long)row * 1024;
    float v[16];
#pragma unroll
    for (int c = 0; c < 4; c++) { float4 t = *(const float4*)(src + (lane + 64 * c) * 4); v[c * 4] = t.x; v[c * 4 + 1] = t.y; v[c * 4 + 2] = t.z; v[c * 4 + 3] = t.w; }
    int b = row >> 13, s = row & 8191;
    int tp = (b << 13) + (s & 63) * 128 + (s >> 6);
    ln16_write(v, p.ln0g, p.ln0b, p.XS + (long)tp * 1024, p.XB + (long)tp * 1024, lane);
  }
  for (int r = bid * 4 + wave; r < 65536; r += nb * 4) {
    const int tb = r >> 15, rr = r & 32767;
    const float* src = (tb ? p.pv : p.pu) + (long)rr * 1024;
    float v[16];
#pragma unroll
    for (int c = 0; c < 4; c++) { float4 t = *(const float4*)(src + (lane + 64 * c) * 4); v[c * 4] = t.x; v[c * 4 + 1] = t.y; v[c * 4 + 2] = t.z; v[c * 4 + 3] = t.w; }
    float am = 0.f;
#pragma unroll
    for (int i = 0; i < 16; i++) am = fmaxf(am, fabsf(v[i]));
    { am = fmaxf(am, shx<32>(am)); am = fmaxf(am, shx<16>(am)); am = fmaxf(am, shx<8>(am)); am = fmaxf(am, shx<4>(am)); am = fmaxf(am, shx<2>(am)); am = fmaxf(am, shx<1>(am)); }
    const float inv = am > 0.f ? 127.f / am : 0.f;
    unsigned char* dst = (tb ? p.V8 : p.U8) + (long)rr * 1024;
#pragma unroll
    for (int c = 0; c < 4; c++) {
      unsigned q0 = (unsigned)((int)rintf(v[c * 4] * inv) + 128), q1 = (unsigned)((int)rintf(v[c * 4 + 1] * inv) + 128);
      unsigned q2 = (unsigned)((int)rintf(v[c * 4 + 2] * inv) + 128), q3 = (unsigned)((int)rintf(v[c * 4 + 3] * inv) + 128);
      *(unsigned*)(dst + (lane + 64 * c) * 4) = q0 | (q1 << 8) | (q2 << 16) | (q3 << 24);
    }
    if (lane == 0) (tb ? p.SV : p.SU)[rr] = am * (1.f / 127.f);
  }
  for (int i = bid * VT + tid; i < 2 * 8 * 2 * 128 * 128 / 8; i += nb * VT) {
    const float* s = p.sk + (long)i * 8;
    float4 a = *(const float4*)s, b = *(const float4*)(s + 4);
    uint4 o; o.x = pack2(a.x, a.y); o.y = pack2(a.z, a.w); o.z = pack2(b.x, b.y); o.w = pack2(b.z, b.w);
    *(uint4*)(p.SK + (long)i * 8) = o;
  }
  {
    float* tile = (float*)smem;
    const int per_layer = 704 + 128 + 128 + 256 + 512;
    for (int it0 = 0; it0 < 2 * per_layer; it0 += nb) {
      int it = it0 + bid; const bool act = it < 2 * per_layer; if (!act) it = 0;
      int l = it / per_layer, r = it % per_layer;
      const float* src; u16* dst; int ldsrc, lddst, kt, nt;
      if (r < 704) { kt = r / 44; nt = r % 44; src = p.w_in + (long)l * 1024 * 3328 + 512; ldsrc = 3328; dst = p.WIN + ((long)l * 3328 + 512) * 1024; lddst = 1024; }
      else if (r < 832) { r -= 704; kt = r / 16; nt = r % 16; src = p.w_bf + (long)l * 512 * 1024; ldsrc = 1024; dst = p.WBF + (long)l * 1024 * 512; lddst = 512; }
      else if (r < 960) { r -= 832; kt = r / 16; nt = r % 16; src = p.w_ba + (long)l * 512 * 1024; ldsrc = 1024; dst = p.WBA + (long)l * 1024 * 512; lddst = 512; }
      else if (r < 1216) { r -= 960; kt = r / 16; nt = r % 16; src = p.w_out + (long)l * 1024 * 1024; ldsrc = 1024; dst = p.WOUT + (long)l * 1024 * 1024; lddst = 1024; }
      else { r -= 1216; kt = r / 32; nt = r % 32; src = p.w_q + (long)l * 1024 * 2048; ldsrc = 2048; dst = p.WQ + (long)l * 2048 * 1024; lddst = 1024; }
      transpose_tile(src + (long)kt * 64 * ldsrc + nt * 64, ldsrc, dst + (long)nt * 64 * lddst + kt * 64, lddst, tile, tid, act);
    }
    __syncthreads();
  }
  {
    float* wt = (float*)smem;
    float* ctab = wt + 16 * 128;
    if (tid < 128) ctab[tid] = cospif((float)tid / 64.f);
    for (int it0 = 0; it0 < 2 * 4 * 64; it0 += nb) {
      int it = it0 + bid; const bool act = it < 2 * 4 * 64; if (!act) it = 0;
      int l = it >> 8, g = (it >> 6) & 3, kt = it & 63;
      __syncthreads();
      for (int e = tid; e < 16 * 32; e += VT) {
        int kr = e >> 5, c4 = (e & 31) * 4;
        *(float4*)(wt + kr * 128 + c4) = *(const float4*)(p.w_in + ((long)l * 1024 + kt * 16 + kr) * 3328 + g * 128 + c4);
      }
      __syncthreads();
      int j = tid & 127, kh = tid >> 7;
      int cp, off; float sgn;
      if (j < 65) { cp = j; off = 0; sgn = 0.08838834764831845f; } else { cp = j - 64; off = 96; sgn = -0.08838834764831845f; }
      float a[8];
#pragma unroll
      for (int q = 0; q < 8; q++) a[q] = 0.f;
      for (int d = 0; d < 128; d++) {
        float bs = ctab[(cp * d + off) & 127];
#pragma unroll
        for (int q = 0; q < 8; q++) a[q] += wt[(kh * 8 + q) * 128 + d] * bs;
      }
      uint4 o; o.x = pack2(a[0] * sgn, a[1] * sgn); o.y = pack2(a[2] * sgn, a[3] * sgn); o.z = pack2(a[4] * sgn, a[5] * sgn); o.w = pack2(a[6] * sgn, a[7] * sgn);
      if (act) *(uint4*)(p.WIN + ((long)l * 3328 + g * 128 + j) * 1024 + kt * 16 + kh * 8) = o;
    }
    __syncthreads();
  }
  for (int i = bid * VT + tid; i < 65536; i += nb * VT) {
    int m = i >> 8, kk = i & 255;
    int mh = m >> 7, po = (m >> 6) & 1, k1 = mh * 64 + (m & 63);
    int pi = kk >> 7, s1 = kk & 127;
    int a = (k1 * s1) & 127;
    float c = cospif((float)a / 64.f), s = sinpif((float)a / 64.f);
    float v = (po == pi) ? c : (po == 0 ? s : -s);
    p.D256[i] = f2bf(v * 0.08838834764831845f);
  }
  for (int i = bid * VT + tid; i < 8192; i += nb * VT) {
    int k2 = i >> 7, kk = i & 127, pi = kk >> 6, s2 = kk & 63;
    int a = (k2 * s2) & 63;
    float v = pi ? sinpif((float)a / 32.f) : cospif((float)a / 32.f);
    p.C64[i] = f2bf(v * 0.125f);
    int k1 = i >> 6, t2 = i & 63;
    float ph = (float)(k1 * t2) / 4096.f;
    p.TW[i] = make_float2(cospif(ph), sinpif(ph));
  }
  for (int i = bid * VT + tid; i < 2048; i += nb * VT) {
    int pos = i >> 4, f = i & 15;
    float inv = 1.0f / powf(10000.f, (float)(2 * f) / 32.f);
    float ang = (float)pos * inv;
    p.ROPE[i] = make_float2(cosf(ang), sinf(ang));
  }
}

DI void inproj_epi_fourier(const P& p, const float* sC, int mt, int g, const int tid) {
  const int b = mt >> 6, s2 = mt & 63;
#pragma unroll 1
  for (int unit = tid; unit < 2048; unit += NTHR) {
    int j = unit >> 4, ch = unit & 15;
    float4 a = *(const float4*)(sC + j * 132 + ch * 8), c = *(const float4*)(sC + j * 132 + ch * 8 + 4);
    uint4 o; o.x = pack2(a.x, a.y); o.y = pack2(a.z, a.w); o.z = pack2(c.x, c.y); o.w = pack2(c.z, c.w);
    int cp = (j < 65) ? j : j - 64, part = (j < 65) ? 0 : 1;
    long rowi = ((long)(b * 4 + g) * 65 + cp) * 64 + s2;
    *(uint4*)(p.ZT + rowi * 256 + part * 128 + ch * 8) = o;
  }
  if (tid < 32) {
    int cp = (tid < 16) ? 0 : 64, ch = tid & 15;
    long rowi = ((long)(b * 4 + g) * 65 + cp) * 64 + s2;
    unsigned z_; asm volatile("v_mov_b32 %0, 0" : "=v"(z_));
    *(uint4*)(p.ZT + rowi * 256 + 128 + ch * 8) = make_uint4(z_, z_, z_, z_);
  }
}
DI void inproj_epi_qk(const P& p, int l, const float* sC, int mt, int nt, const int tid) {
  const int b = mt >> 6, s2 = mt & 63;
  if (tid < 256) {
    const int row = tid & 127, hd = tid >> 7;
    const float* sr = sC + row * 132 + hd * 64;
    float ss = 0.f;
#pragma unroll
    for (int i = 0; i < 16; i++) { float4 t = *(const float4*)(sr + i * 4); ss += t.x * t.x + t.y * t.y + t.z * t.z + t.w * t.w; }
    const bool isq = nt < 8;
    const float* gn = (isq ? p.qng : p.kng) + l * 64;
    const float rinv = rsqrtf(ss * (1.f / 64.f) + 1e-6f) * (isq ? (0.125f * 1.4426950408889634f) : 1.f);
    const int s1 = row;
    const int u = s2 * 128 + s1;
    u16* dst;
    if (isq) { int h = (nt - 4) * 2 + hd; dst = p.Q + ((long)(b * 8 + h) * 8192 + u) * 64; }
    else { dst = p.K + ((long)(b * 2 + hd) * 8192 + u) * 64; }
#pragma unroll 1
    for (int ax = 0; ax < 2; ax++) {
      const int pos = ax ? s2 : s1;
#pragma unroll 1
      for (int fq = 0; fq < 2; fq++) {
        float x0[8], x1[8], o0[8], o1[8];
#pragma unroll
        for (int e = 0; e < 8; e++) {
          int d0 = ax * 32 + fq * 8 + e, d1 = d0 + 16;
          x0[e] = sr[d0] * rinv * gn[d0];
          x1[e] = sr[d1] * rinv * gn[d1];
          float2 cs = p.ROPE[pos * 16 + fq * 8 + e];
          o0[e] = x0[e] * cs.x - x1[e] * cs.y;
          o1[e] = x1[e] * cs.x + x0[e] * cs.y;
        }
        uint4 pk;
        pk.x = pack2(o0[0], o0[1]); pk.y = pack2(o0[2], o0[3]); pk.z = pack2(o0[4], o0[5]); pk.w = pack2(o0[6], o0[7]);
        *(uint4*)(dst + ax * 32 + fq * 8) = pk;
        pk.x = pack2(o1[0], o1[1]); pk.y = pack2(o1[2], o1[3]); pk.z = pack2(o1[4], o1[5]); pk.w = pack2(o1[6], o1[7]);
        *(uint4*)(dst + ax * 32 + 16 + fq * 8) = pk;
      }
    }
  }
}
DI void inproj_epi_v(const P& p, const float* sC, int mt, const int tid) {
  const int b = mt >> 6, s2 = mt & 63;
#pragma unroll 1
  for (int unit = tid; unit < 2048; unit += NTHR) {
    int j = unit >> 4, ch = unit & 15;
    float4 a = *(const float4*)(sC + j * 132 + ch * 8), c = *(const float4*)(sC + j * 132 + ch * 8 + 4);
    uint4 o; o.x = pack2(a.x, a.y); o.y = pack2(a.z, a.w); o.z = pack2(c.x, c.y); o.w = pack2(c.z, c.w);
    *(uint4*)(p.VT + ((long)(b * 2) * 64 + j) * 8192 + s2 * 128 + ch * 8) = o;
  }
}
DI void inproj_epi_gates(const P& p, int l, const float* sC, int mt, int nt, const int tid) {
  const int c0 = (nt - 10) * 128;
  const float* bg = p.b_gate + l * 2048 + c0;
#pragma unroll 1
  for (int unit = tid; unit < 2048; unit += NTHR) {
    int row = unit >> 4, ch = unit & 15;
    float4 a = *(const float4*)(sC + row * 132 + ch * 8), c = *(const float4*)(sC + row * 132 + ch * 8 + 4);
    float4 ba = *(const float4*)(bg + ch * 8), bc = *(const float4*)(bg + ch * 8 + 4);
    float r0 = 1.f / (1.f + __expf(-(a.x + ba.x))), r1 = 1.f / (1.f + __expf(-(a.y + ba.y)));
    float r2 = 1.f / (1.f + __expf(-(a.z + ba.z))), r3 = 1.f / (1.f + __expf(-(a.w + ba.w)));
    float r4 = 1.f / (1.f + __expf(-(c.x + bc.x))), r5 = 1.f / (1.f + __expf(-(c.y + bc.y)));
    float r6 = 1.f / (1.f + __expf(-(c.z + bc.z))), r7 = 1.f / (1.f + __expf(-(c.w + bc.w)));
    uint4 o; o.x = pack2(r0, r1); o.y = pack2(r2, r3); o.z = pack2(r4, r5); o.w = pack2(r6, r7);
    NTS4(p.GATES + ((long)mt * 128 + row) * 2048 + c0 + ch * 8, o);
  }
}

DI void ph_inproj(const P& p, int l, char* smem, int bid, int nb, const Xcd xc) {
  const int tid = opaque_tid();
  float* sC = (float*)smem;
  const u16* W = p.WIN + (long)l * 3328 * 1024;
  XCD_TILE_LOOP(64, 12, mt2, nt2) {
    f32x16 acc[4][2];
    zero_acc<4>(acc);
    gemm_main<4>(p.XB + (long)mt2 * 256 * 1024, 1024, W + (long)nt2 * 256 * 1024, 1024, 1024, acc, smem, tid, 0);
#pragma unroll 1
    for (int q = 0; q < 4; q++) {
      const int mh = q >> 1, nh = q & 1, mt = mt2 * 2 + mh, nt = nt2 * 2 + nh;
      if (nt < 4) { stage_q_tr(acc, sC, tid, mh, nh); inproj_epi_fourier(p, sC, mt, nt, opaque_tid()); }
      else if (nt < 9) { stage_q(acc, sC, tid, mh, nh); inproj_epi_qk(p, l, sC, mt, nt, opaque_tid()); }
      else if (nt == 9) { stage_q_tr(acc, sC, tid, mh, nh); inproj_epi_v(p, sC, mt, opaque_tid()); }
      else { stage_q(acc, sC, tid, mh, nh); inproj_epi_gates(p, l, sC, mt, nt, opaque_tid()); }
      __syncthreads();
    }
  }
  for (int j_ = xc.slot; j_ < 32; j_ += xc.n) {
    const int mt4 = xc.id * 32 + j_;
    f32x16 acc1[1][2];
    zero_acc<1>(acc1);
    gemm_main<1>(p.XB + (long)mt4 * 64 * 1024, 1024, W + (long)12 * 256 * 1024, 1024, 1024, acc1, smem, tid, 0);
#pragma unroll 1
    for (int nh = 0; nh < 2; nh++) {
      stage_h1(acc1, sC, tid, nh);
      const int c0 = (24 + nh - 10) * 128;
      const float* bg = p.b_gate + l * 2048 + c0;
#pragma unroll 1
      for (int unit = opaque_tid(); unit < 1024; unit += NTHR) {
        int row = unit >> 4, ch = unit & 15;
        float4 a = *(const float4*)(sC + row * 132 + ch * 8), c = *(const float4*)(sC + row * 132 + ch * 8 + 4);
        float4 ba = *(const float4*)(bg + ch * 8), bc = *(const float4*)(bg + ch * 8 + 4);
        float r0 = 1.f / (1.f + __expf(-(a.x + ba.x))), r1 = 1.f / (1.f + __expf(-(a.y + ba.y)));
        float r2 = 1.f / (1.f + __expf(-(a.z + ba.z))), r3 = 1.f / (1.f + __expf(-(a.w + ba.w)));
        float r4 = 1.f / (1.f + __expf(-(c.x + bc.x))), r5 = 1.f / (1.f + __expf(-(c.y + bc.y)));
        float r6 = 1.f / (1.f + __expf(-(c.z + bc.z))), r7 = 1.f / (1.f + __expf(-(c.w + bc.w)));
        uint4 o; o.x = pack2(r0, r1); o.y = pack2(r2, r3); o.z = pack2(r4, r5); o.w = pack2(r6, r7);
        NTS4(p.GATES + ((long)mt4 * 64 + row) * 2048 + c0 + ch * 8, o);
      }
      __syncthreads();
    }
  }
}

DI void ph_fftA(const P& p, char* smem, int bid, int nb) {
  const int tid = opaque_tid();
  float* sC = (float*)smem;
  for (int t2 = bid; t2 < 130; t2 += nb) {
    f32x16 acc[4][2];
    zero_acc<4>(acc);
    gemm_main<4>(p.D256, 256, p.ZT + (long)t2 * 256 * 256, 256, 256, acc, smem, tid, t2);
#pragma unroll 1
    for (int q = 0; q < 4; q++) {
      const int mh = q >> 1, nh = q & 1, ntile = t2 * 2 + nh;
      stage_q(acc, sC, tid, mh, nh);
      if (tid < 256) {
        const int k1l = tid & 63, ch = (tid >> 6) & 1, po = tid >> 7;
        const int k1 = mh * 64 + k1l;
        const int qd = ntile * 2 + ch, bg = qd / 65, cp = qd % 65;
        u16* dst = p.GP + (((long)bg * 128 + k1) * 65 + cp) * 128 + po * 64;
        const float2* tw = p.TW + k1 * 64;
#pragma unroll 2
        for (int i = 0; i < 8; i++) {
          float o[8];
#pragma unroll
          for (int e = 0; e < 8; e++) {
            int s2 = i * 8 + e;
            float gr = sC[k1l * 132 + ch * 64 + s2], gi = sC[(64 + k1l) * 132 + ch * 64 + s2];
            float2 cs = tw[s2];
            o[e] = po ? (gi * cs.x - gr * cs.y) : (gr * cs.x + gi * cs.y);
          }
          uint4 pk; pk.x = pack2(o[0], o[1]); pk.y = pack2(o[2], o[3]); pk.z = pack2(o[4], o[5]); pk.w = pack2(o[6], o[7]);
          *(uint4*)(dst + i * 8) = pk;
        }
      }
      __syncthreads();
    }
  }
}

DI void ph_fftC(const P& p, char* smem, int bid, int nb) {
  const int tid = opaque_tid();
  float* sC = (float*)smem;
  for (int t2 = bid; t2 < 260; t2 += nb) {
    f32x16 acc[1][2];
    zero_acc<1>(acc);
    gemm_main<1>(p.C64, 128, p.GP + (long)t2 * 256 * 128, 128, 128, acc, smem, tid, 0);
#pragma unroll 1
    for (int nh = 0; nh < 2; nh++) {
      stage_h1(acc, sC, tid, nh);
      const int tile = t2 * 2 + nh;
      const int nl = tid & 127, kh = tid >> 7;
      const int idx = tile * 128 + nl;
      const int cp = idx % 65, k1 = (idx / 65) & 127, bg = idx / (65 * 128);
      const int b = bg >> 2, g = bg & 3;
      const bool mir = (cp >= 1 && cp <= 63);
      for (int i = 0; i < 16; i++) {
        int k2 = kh * 16 + i;
        u16 v = f2bf(sC[k2 * 132 + nl]);
        int k = k1 + 128 * k2;
        long tp = (long)b * 8192 + (k & 63) * 128 + (k >> 6);
        p.Y[tp * 512 + g * 128 + cp] = v;
        if (mir) {
          int km = (8192 - k) & 8191;
          long tm = (long)b * 8192 + (km & 63) * 128 + (km >> 6);
          p.Y[tm * 512 + g * 128 + 128 - cp] = v;
        }
      }
      __syncthreads();
    }
  }
}

DI void attn_item(const P& p, int l, int item, char* smem, const int tid, const int rot, const bool late) {
  const int lane = tid & 63, wave = tid >> 6;
  const int hg = item & 3, qb = (item >> 2) & 31, kvh = (item >> 7) & 1, b = item >> 8;
  const int h = kvh * 4 + hg;
  const int ql = lane & 31, hf = lane >> 5;
  const u16* Qp = p.Q + ((long)(b * 8 + h) * 8192 + qb * 256 + wave * 64) * 64;
  const u16* Kp = p.K + (long)(b * 2 + kvh) * 8192 * 64;
  const u16* Vp = p.VT + (long)(b * 2 + kvh) * 64 * 8192;
  u16* sK = (u16*)smem;
  u16* sV = sK + 3 * 64 * 72;
  f32x16 o[2][2];
#pragma unroll
  for (int dt = 0; dt < 2; dt++)
#pragma unroll
    for (int qt = 0; qt < 2; qt++)
#pragma unroll
      for (int r = 0; r < 16; r++) o[dt][qt][r] = 0.f;
  f32x2 ls[2] = {f32x2{0.f, 0.f}, f32x2{0.f, 0.f}};
  const int lr = tid >> 3, lc = (tid & 7) * 8;
  u32x4 rk[2], rv[2];
  __syncthreads();
#pragma unroll
  for (int c = 0; c < 2; c++) {
    rk[c] = *(const u32x4*)((const char*)Kp + ((long)(rot & 127) * 8192 + c * 4096) + (unsigned)((lr * 64 + lc) * 2));
    rv[c] = *(const u32x4*)((const char*)Vp + ((long)(rot & 127) * 128 + (long)c * 32 * 8192 * 2) + (unsigned)((lr * 8192 + lc) * 2));
  }
#pragma unroll
  for (int c = 0; c < 2; c++) {
    *(u32x4*)(sK + (lr + 32 * c) * 72 + lc) = rk[c];
    *(u32x4*)(sV + (lr + 32 * c) * 72 + lc) = rv[c];
  }
  __syncthreads();
  __builtin_amdgcn_sched_barrier(0);
  bf16x8 qf[2][4];
  float bound[2];
  float kmax = fabsf(p.kng[l * 64 + lane]);
  { kmax = fmaxf(kmax, shx<32>(kmax)); kmax = fmaxf(kmax, shx<16>(kmax)); kmax = fmaxf(kmax, shx<8>(kmax)); kmax = fmaxf(kmax, shx<4>(kmax)); kmax = fmaxf(kmax, shx<2>(kmax)); kmax = fmaxf(kmax, shx<1>(kmax)); }
  kmax *= 8.f * 1.02f;
#pragma unroll
  for (int qt = 0; qt < 2; qt++) {
    float ssq = 0.f;
#pragma unroll
    for (int kd = 0; kd < 4; kd++) {
      qf[qt][kd] = *(const bf16x8*)((const char*)Qp + (long)((qt * 32 * 64 + kd * 16) * 2) + (unsigned)((ql * 64 + hf * 8) * 2));
#pragma unroll
      for (int j = 0; j < 8; j++) { float v = bf2f((u16)qf[qt][kd][j]); ssq += v * v; }
    }
    ssq += shx<32>(ssq);
    bound[qt] = sqrtf(ssq) * kmax;
    __builtin_amdgcn_sched_barrier(0);
  }
  const unsigned offK = (unsigned)((lr * 64 + lc) * 2), offV = (unsigned)((lr * 8192 + lc) * 2);
  const char* Kb = (const char*)Kp;
  const char* Vb = (const char*)Vp;
#define ATT_LOAD(ktile)                                                                                   \
  { const long tk_ = (long)(((ktile) + rot) & 127);                                                       \
    rk[0] = *(const u32x4*)(Kb + tk_ * 8192 + offK); rk[1] = *(const u32x4*)(Kb + (tk_ * 8192 + 4096) + offK);          \
    rv[0] = *(const u32x4*)(Vb + tk_ * 128 + offV);  rv[1] = *(const u32x4*)(Vb + (tk_ * 128 + 32 * 8192 * 2) + offV); }
#define ATT_STORE(buf3)                                                                                   \
  { u16* nK = sK + (buf3) * 64 * 72; u16* nV = sV + (buf3) * 64 * 72;                                     \
    _Pragma("unroll") for (int c = 0; c < 2; c++) {                                                       \
      *(u32x4*)(nK + (lr + 32 * c) * 72 + lc) = rk[c];                                                    \
      *(u32x4*)(nV + (lr + 32 * c) * 72 + lc) = rv[c];                                                    \
    } }
#define ATT_KS(ks)                                                                                        \
    {                                                                                                     \
      f32x16 st[2];                                                                                       \
      _Pragma("unroll") for (int qt = 0; qt < 2; qt++)                                                    \
        _Pragma("unroll") for (int r = 0; r < 16; r++) st[qt][r] = -bound[qt];                            \
      _Pragma("unroll") for (int kd = 0; kd < 4; kd++) {                                                  \
        bf16x8 kf = *(const bf16x8*)(cK + ((ks) * 32 + ql) * 72 + kd * 16 + hf * 8);                      \
        _Pragma("unroll") for (int qt = 0; qt < 2; qt++) st[qt] = MFMA(kf, qf[qt][kd], st[qt]);           \
      }                                                                                                   \
      _Pragma("unroll") for (int qt = 0; qt < 2; qt++)                                                    \
        _Pragma("unroll") for (int r = 0; r < 16; r += 2) {                                               \
          float e0 = __builtin_amdgcn_exp2f(st[qt][r]), e1 = __builtin_amdgcn_exp2f(st[qt][r + 1]);      \
          st[qt][r] = e0; st[qt][r + 1] = e1;                                                             \
          ls[qt] += f32x2{e0, e1};                                                                        \
        }                                                                                                 \
      _Pragma("unroll") for (int s = 0; s < 2; s++) {                                                     \
        bf16x8 pf[2];                                                                                     \
        _Pragma("unroll") for (int qt = 0; qt < 2; qt++)                                                  \
          _Pragma("unroll") for (int j = 0; j < 8; j++) pf[qt][j] = (short)f2bf(st[qt][8 * s + j]);       \
        _Pragma("unroll") for (int dt = 0; dt < 2; dt++) {                                                \
          const u16* vp = cV + (dt * 32 + ql) * 72 + (ks) * 32 + 16 * s + 4 * hf;                         \
          s16x4 lo = *(const s16x4*)vp, hi = *(const s16x4*)(vp + 8);                                     \
          bf16x8 vf = __builtin_shufflevector(lo, hi, 0, 1, 2, 3, 4, 5, 6, 7);                            \
          _Pragma("unroll") for (int qt = 0; qt < 2; qt++) o[dt][qt] = MFMA(vf, pf[qt], o[dt][qt]);       \
        }                                                                                                 \
      }                                                                                                   \
      __builtin_amdgcn_sched_barrier(0);                                                                  \
    }
  if (late) { ATT_LOAD(1) }
  int cur3 = 0;
  for (int kt = 0; kt < 128; kt++) {
    const int nxt3 = (cur3 == 2) ? 0 : cur3 + 1;
    const u16* cK = sK + cur3 * 64 * 72;
    const u16* cV = sV + cur3 * 64 * 72;
    if (!late) { if (kt + 1 < 128) { ATT_LOAD(kt + 1) } }
    ATT_KS(0)
    if (late) {
      if (kt + 1 < 128) { ATT_STORE(nxt3) }
      __syncthreads();
      if (kt + 2 < 128) { ATT_LOAD(kt + 2) }
    }
    ATT_KS(1)
    if (!late) {
      if (kt + 1 < 128) { ATT_STORE(nxt3) }
      __syncthreads();
    }
    cur3 = nxt3;
  }
  __syncthreads();
#undef ATT_LOAD
#undef ATT_STORE
#undef ATT_KS
  const int te_ = opaque_vtid();
  const int lane_e = te_ & 63, wave_e = te_ >> 6, ql_e = lane_e & 31, hf_e = lane_e >> 5;
  u16* sO = (u16*)smem + wave_e * 64 * 72;
#pragma unroll
  for (int qt = 0; qt < 2; qt++) {
    float lt = ls[qt].x + ls[qt].y;
    lt += shx<32>(lt);
    const float inv = 1.f / lt;
#pragma unroll
    for (int dt = 0; dt < 2; dt++)
#pragma unroll
      for (int rq = 0; rq < 4; rq++) {
        int d = dt * 32 + 8 * rq + 4 * hf_e;
        uint2 pk; pk.x = pack2(o[dt][qt][rq * 4] * inv, o[dt][qt][rq * 4 + 1] * inv); pk.y = pack2(o[dt][qt][rq * 4 + 2] * inv, o[dt][qt][rq * 4 + 3] * inv);
        *(uint2*)(sO + (qt * 32 + ql_e) * 72 + d) = pk;
      }
  }
  __syncthreads();
  u16* dst = p.AO + ((long)b * 8192 + qb * 256 + wave_e * 64) * 512 + h * 64;
#pragma unroll 2
  for (int i = 0; i < 8; i++) {
    int unit = lane_e + 64 * i, q = unit >> 3, ch = unit & 7;
    *(uint4*)(dst + (long)q * 512 + ch * 8) = *(const uint4*)(sO + q * 72 + ch * 8);
  }
  __syncthreads();
}

DI void ph_attn(const P& p, int l, char* smem, const Xcd xc, const int vb) {
  const int tid = opaque_vtid();
  for (int base = xc.slot * 2; base < 64; base += xc.n * 2) {
    const int sl = base + vb;
    attn_item(p, l, ((xc.id >> 1) << 7) | ((xc.id & 1) << 6) | sl, smem, tid, sl * 2, vb != 0);
  }
}

DI void ph_branch(const P& p, int l, char* smem, int bid, int nb, const Xcd xc) {
  const int tid = opaque_tid();
  float* sC = (float*)smem;
  XCD_TILE_LOOP(64, 4, mt2, nt2) {
    f32x16 a1[4][2];
    zero_acc<4>(a1);
    gemm_main<4>(p.Y + (long)mt2 * 256 * 512, 512, p.WBF + ((long)l * 1024 + nt2 * 256) * 512, 512, 512, a1, smem, tid, 0);
#pragma unroll 1
    for (int q = 0; q < 4; q++) {
      const int mh = q >> 1, nh = q & 1, mt = mt2 * 2 + mh, nt = nt2 * 2 + nh;
      stage_q(a1, sC, tid, mh, nh);
#pragma unroll 1
      for (int unit = opaque_tid(); unit < 2048; unit += NTHR) {
        int row = unit >> 4, ch = unit & 15;
        const u16* gp = p.GATES + ((long)mt * 128 + row) * 2048 + nt * 128 + ch * 8;
        uint4 gf = *(const uint4*)gp, ga = *(const uint4*)(gp + 1024);
        float* sp = sC + row * 132 + ch * 8;
        float4 a = *(const float4*)sp, c = *(const float4*)(sp + 4);
        a.x *= bflo(gf.x) / fmaxf(bflo(ga.x), 1e-20f); a.y *= bfhi(gf.x) / fmaxf(bfhi(ga.x), 1e-20f);
        a.z *= bflo(gf.y) / fmaxf(bflo(ga.y), 1e-20f); a.w *= bfhi(gf.y) / fmaxf(bfhi(ga.y), 1e-20f);
        c.x *= bflo(gf.z) / fmaxf(bflo(ga.z), 1e-20f); c.y *= bfhi(gf.z) / fmaxf(bfhi(ga.z), 1e-20f);
        c.z *= bflo(gf.w) / fmaxf(bflo(ga.w), 1e-20f); c.w *= bfhi(gf.w) / fmaxf(bfhi(ga.w), 1e-20f);
        *(float4*)sp = a; *(float4*)(sp + 4) = c;
      }
      __syncthreads();
      unstage_q(a1, sC, tid, mh, nh);
    }
    gemm_main<4>(p.AO + (long)mt2 * 256 * 512, 512, p.WBA + ((long)l * 1024 + nt2 * 256) * 512, 512, 512, a1, smem, tid, 0);
#pragma unroll 1
    for (int q = 0; q < 4; q++) {
      const int mh = q >> 1, nh = q & 1, mt = mt2 * 2 + mh, nt = nt2 * 2 + nh;
      stage_q(a1, sC, tid, mh, nh);
#pragma unroll 1
      for (int unit = opaque_tid(); unit < 2048; unit += NTHR) {
        int row = unit >> 4, ch = unit & 15;
        uint4 ga = *(const uint4*)(p.GATES + ((long)mt * 128 + row) * 2048 + 1024 + nt * 128 + ch * 8);
        float4 a = *(const float4*)(sC + row * 132 + ch * 8), c = *(const float4*)(sC + row * 132 + ch * 8 + 4);
        uint4 o;
        o.x = pack2(a.x * fmaxf(bflo(ga.x), 1e-20f), a.y * fmaxf(bfhi(ga.x), 1e-20f));
        o.y = pack2(a.z * fmaxf(bflo(ga.y), 1e-20f), a.w * fmaxf(bfhi(ga.y), 1e-20f));
        o.z = pack2(c.x * fmaxf(bflo(ga.z), 1e-20f), c.y * fmaxf(bfhi(ga.z), 1e-20f));
        o.w = pack2(c.z * fmaxf(bflo(ga.w), 1e-20f), c.w * fmaxf(bfhi(ga.w), 1e-20f));
        NTS4(p.MIXED + ((long)mt * 128 + row) * 1024 + nt * 128 + ch * 8, o);
      }
      __syncthreads();
    }
  }
}

DI void ph_outproj(const P& p, int l, char* smem, int bid, int nb, const Xcd xc) {
  const int tid = opaque_tid();
  float* sC = (float*)smem;
  XCD_TILE_LOOP(64, 4, mt2, nt2) {
    f32x16 acc[4][2];
    zero_acc<4>(acc);
    gemm_main<4>(p.MIXED + (long)mt2 * 256 * 1024, 1024, p.WOUT + ((long)l * 1024 + nt2 * 256) * 1024, 1024, 1024, acc, smem, tid, 0);
#pragma unroll 1
    for (int q = 0; q < 4; q++) {
      const int mh = q >> 1, nh = q & 1, mt = mt2 * 2 + mh, nt = nt2 * 2 + nh;
      stage_q(acc, sC, tid, mh, nh);
#pragma unroll 1
      for (int unit = opaque_tid(); unit < 2048; unit += NTHR) {
        int row = unit >> 4, ch = unit & 15;
        long gi = ((long)mt * 128 + row) * 1024 + nt * 128 + ch * 8;
        float4 a = *(const float4*)(sC + row * 132 + ch * 8), c = *(const float4*)(sC + row * 132 + ch * 8 + 4);
        float4 xa = *(const float4*)(p.XS + gi), xc4 = *(const float4*)(p.XS + gi + 4);
        a.x += ALPHA * xa.x; a.y += ALPHA * xa.y; a.z += ALPHA * xa.z; a.w += ALPHA * xa.w;
        c.x += ALPHA * xc4.x; c.y += ALPHA * xc4.y; c.z += ALPHA * xc4.z; c.w += ALPHA * xc4.w;
        NTSF4(p.out + gi, a); NTSF4(p.out + gi + 4, c);
      }
      __syncthreads();
    }
  }
}

DI void ph_ln1(const P& p, int l, int bid, int nb) {
  const int tid = opaque_vtid(), lane = tid & 63, wave = tid >> 6;
  for (int row = bid * 4 + wave; row < T; row += nb * 4) {
    const float* src = p.out + (long)row * 1024;
    float v[16];
#pragma unroll
    for (int c = 0; c < 4; c++) { float4 t = *(const float4*)(src + (lane + 64 * c) * 4); v[c * 4] = t.x; v[c * 4 + 1] = t.y; v[c * 4 + 2] = t.z; v[c * 4 + 3] = t.w; }
    ln16_write(v, p.ln1g + l * 1024, p.ln1b + l * 1024, p.XS + (long)row * 1024, p.XB + (long)row * 1024, lane);
  }
}

DI void ph_peerq(const P& p, int l, char* smem, int bid, int nb, const Xcd xc) {
  const int tid = opaque_tid();
  float* sC = (float*)smem;
  XCD_TILE_LOOP(64, 8, mt2, nt2) {
    f32x16 acc[4][2];
    zero_acc<4>(acc);
    gemm_main<4>(p.XB + (long)mt2 * 256 * 1024, 1024, p.WQ + ((long)l * 2048 + nt2 * 256) * 1024, 1024, 1024, acc, smem, tid, 0);
#pragma unroll 1
    for (int q = 0; q < 4; q++) {
      const int mh = q >> 1, nh = q & 1, mt = mt2 * 2 + mh, nt = nt2 * 2 + nh;
      stage_q(acc, sC, tid, mh, nh);
#pragma unroll 1
      for (int unit = opaque_tid(); unit < 2048; unit += NTHR) {
        int row = unit >> 4, ch = unit & 15;
        float4 a = *(const float4*)(sC + row * 132 + ch * 8), c = *(const float4*)(sC + row * 132 + ch * 8 + 4);
        uint4 o; o.x = pack2(a.x, a.y); o.y = pack2(a.z, a.w); o.z = pack2(c.x, c.y); o.w = pack2(c.z, c.w);
        NTS4(p.QP + ((long)mt * 128 + row) * 2048 + nt * 128 + ch * 8, o);
      }
      __syncthreads();
    }
  }
}

DI int okey(float v) { int b = __float_as_int(v); return b ^ ((b >> 31) & 0x7fffffff); }
DI float okey_val(int k) { return __int_as_float(k ^ ((k >> 31) & 0x7fffffff)); }
DI int med3i(int a, int b, int c) { int r; asm("v_med3_i32 %0, %1, %2, %3" : "=v"(r) : "v"(a), "v"(b), "v"(c)); return r; }
DI void ins16(int (&L)[16], int x) {
#pragma unroll
  for (int i = 15; i > 0; i--) L[i] = med3i(L[i - 1], L[i], x);
  L[0] = max(L[0], x);
}

DI void peer_finish_token(const P& p, int l, bool last, const long tok, f32x2 (&acc2)[8], float csum, const int lane) {
      float acc[16];
#pragma unroll
      for (int i = 0; i < 8; i++) { acc[2 * i] = acc2[i].x; acc[2 * i + 1] = acc2[i].y; }
      csum *= 128.f;
      const float* xs = p.XS + tok * 1024 + lane * 16;
      float y[16];
#pragma unroll
      for (int c = 0; c < 4; c++) {
        float4 a = *(const float4*)(xs + c * 4);
        y[c * 4 + 0] = ALPHA * a.x + acc[c * 4 + 0] - csum; y[c * 4 + 1] = ALPHA * a.y + acc[c * 4 + 1] - csum;
        y[c * 4 + 2] = ALPHA * a.z + acc[c * 4 + 2] - csum; y[c * 4 + 3] = ALPHA * a.w + acc[c * 4 + 3] - csum;
      }
      float s = 0.f;
#pragma unroll
      for (int i = 0; i < 16; i++) s += y[i];
      float mu = wave_sum(s) * (1.f / 1024.f);
      float q = 0.f;
#pragma unroll
      for (int i = 0; i < 16; i++) { float dd = y[i] - mu; q += dd * dd; }
      float rstd = rsqrtf(wave_sum(q) * (1.f / 1024.f) + 1e-5f);
      const float* g = p.ln2g + l * 1024;
      const float* bt = p.ln2b + l * 1024;
      float* dstf;
      if (last) {
        int b = (int)(tok >> 13), u = (int)(tok & 8191);
        int sact = (u & 127) * 64 + (u >> 7);
        dstf = p.out + ((long)b * 8192 + sact) * 1024;
      } else dstf = p.XS + tok * 1024;
      {
        const int e0 = lane * 16;
        float o[16];
#pragma unroll
        for (int c = 0; c < 4; c++) {
          float4 g0 = *(const float4*)(g + e0 + c * 4), b0 = *(const float4*)(bt + e0 + c * 4);
          o[c * 4 + 0] = (y[c * 4 + 0] - mu) * rstd * g0.x + b0.x; o[c * 4 + 1] = (y[c * 4 + 1] - mu) * rstd * g0.y + b0.y;
          o[c * 4 + 2] = (y[c * 4 + 2] - mu) * rstd * g0.z + b0.z; o[c * 4 + 3] = (y[c * 4 + 3] - mu) * rstd * g0.w + b0.w;
          *(float4*)(dstf + e0 + c * 4) = make_float4(o[c * 4], o[c * 4 + 1], o[c * 4 + 2], o[c * 4 + 3]);
        }
        if (!last) {
          uint4 pk; pk.x = pack2(o[0], o[1]); pk.y = pack2(o[2], o[3]); pk.z = pack2(o[4], o[5]); pk.w = pack2(o[6], o[7]);
          *(uint4*)(p.XB + tok * 1024 + e0) = pk;
          pk.x = pack2(o[8], o[9]); pk.y = pack2(o[10], o[11]); pk.z = pack2(o[12], o[13]); pk.w = pack2(o[14], o[15]);
          *(uint4*)(p.XB + tok * 1024 + e0 + 8) = pk;
        }
      }
}

DI void ph_peer(const P& p, int l, char* smem, int bid, int nb, bool last) {
  const int tid = opaque_vtid(), lane = tid & 63, wave = tid >> 6;
  const int tl = lane & 31, hf = lane >> 5;
  int* sel_e = (int*)smem;
  float* sel_w = (float*)(smem + 16384);
  unsigned char* sidx = (unsigned char*)(smem + 32768);
  float* scoef = (float*)(smem + 32768 + 4096);
  const u16* SKl = p.SK + (long)l * 8 * 2 * 128 * 128;
  const unsigned char* Ul = p.U8 + (long)l * 16384 * 1024;
  const unsigned char* Vl = p.V8 + (long)l * 16384 * 1024;
  const float* SUl = p.SU + l * 16384;
  const float* SVl = p.SV + l * 16384;
  for (int tk = bid; tk < T / 32; tk += nb) {
    const int t0 = tk * 32;
    const int tidr_ = opaque_vtid();
    const int lane = tidr_ & 63, wave = tidr_ >> 6, tl = lane & 31, hf = lane >> 5;
    __syncthreads();
    for (int hi = 0; hi < 2; hi++) {
      const int hh = wave + 4 * hi;
      int L1[16], L2[16];
#pragma unroll
      for (int half = 0; half < 2; half++) {
        f32x16 acc[4];
#pragma unroll
        for (int mt = 0; mt < 4; mt++)
#pragma unroll
          for (int r = 0; r < 16; r++) acc[mt][r] = 0.f;
        const u16* qrow = p.QP + (long)(t0 + tl) * 2048 + hh * 256 + half * 128 + hf * 8;
        const u16* krow = SKl + ((long)(hh * 2 + half) * 128 + tl) * 128 + hf * 8;
#pragma unroll
        for (int kd = 0; kd < 8; kd++) {
          bf16x8 bq = *(const bf16x8*)(qrow + kd * 16);
#pragma unroll
          for (int mt = 0; mt < 4; mt++) {
            bf16x8 ak = *(const bf16x8*)(krow + (long)mt * 32 * 128 + kd * 16);
            acc[mt] = MFMA(ak, bq, acc[mt]);
          }
          if (kd == 3) __builtin_amdgcn_sched_barrier(0);
        }
        int L[16];
#pragma unroll
        for (int i = 0; i < 16; i++) L[i] = (int)0x80000000;
#pragma unroll
        for (int mt = 0; mt < 4; mt++)
#pragma unroll
          for (int r = 0; r < 16; r++) {
            int key = mt * 32 + 8 * (r >> 2) + 4 * hf + (r & 3);
            int k = (okey(acc[mt][r]) & ~0x7f) | (127 - key);
            ins16(L, k);
          }
        int S[16];
#pragma unroll
        for (int i = 0; i < 16; i++) S[i] = L[i];
#pragma unroll
        for (int i = 0; i < 16; i++) { int pv = shxi<32>(S[i]); ins16(L, pv); }
        if (half == 0) {
#pragma unroll
          for (int i = 0; i < 16; i++) L1[i] = L[i];
        } else {
#pragma unroll
          for (int i = 0; i < 16; i++) L2[i] = L[i];
        }
      }
      float v1[16], v2[16];
#pragma unroll
      for (int i = 0; i < 16; i++) { v1[i] = okey_val(L1[i] & ~0x7f); v2[i] = okey_val(L2[i] & ~0x7f); }
      unsigned char* myidx = sidx + (wave * 32 + tl) * 32;
      if (hf == 0) {
#pragma unroll
        for (int i = 0; i < 16; i++) { myidx[i] = (unsigned char)(127 - (L1[i] & 0x7f)); myidx[16 + i] = (unsigned char)(127 - (L2[i] & 0x7f)); }
      }
      int C[16];
#pragma unroll
      for (int i = 0; i < 16; i++) C[i] = (int)0x80000000;
#pragma unroll
      for (int i = 0; i < 16; i++)
#pragma unroll
        for (int j = 0; j < 16; j++)
          if ((i + 1) * (j + 1) <= 16) {
            int k = (okey(v1[i] + v2[j]) & ~0xff) | (255 - (i * 16 + j));
            ins16(C, k);
          }
      float sv[16];
#pragma unroll
      for (int r = 0; r < 16; r++) sv[r] = okey_val(C[r] & ~0xff);
      float den = 0.f;
      {
        float top = sv[0];
#pragma unroll
        for (int r = 0; r < 16; r++) { sv[r] = __expf(sv[r] - top); den += sv[r]; }
      }
      float rden = 1.f / den;
#pragma unroll
      for (int r = 0; r < 16; r++) {
        if ((r >> 3) == hf) {
          int pos = 255 - (C[r] & 0xff);
          int i1 = myidx[pos >> 4], i2 = myidx[16 + (pos & 15)];
          sel_e[tl * 128 + hh * 16 + r] = i1 * 128 + i2;
          sel_w[tl * 128 + hh * 16 + r] = sv[r] * rden;
        }
      }
    }
    __syncthreads();
    int* nlo_tab = (int*)sidx;
    for (int tt = wave; tt < 32; tt += 4) {
      const int e0_ = sel_e[tt * 128 + lane], e1_ = sel_e[tt * 128 + lane + 64];
      const float w0_ = sel_w[tt * 128 + lane], w1_ = sel_w[tt * 128 + lane + 64];
      const bool lo0 = e0_ < 8192, lo1 = e1_ < 8192;
      const unsigned long long m0 = __ballot(lo0), m1 = __ballot(lo1);
      const unsigned long long lt = (1ull << lane) - 1ull;
      const int c0 = __popcll(m0), c1 = __popcll(m1), nlo = c0 + c1;
      const int p0 = lo0 ? __popcll(m0 & lt) : nlo + __popcll(~m0 & lt);
      const int p1 = lo1 ? c0 + __popcll(m1 & lt) : nlo + (64 - c0) + __popcll(~m1 & lt);
      __builtin_amdgcn_wave_barrier();
      sel_e[tt * 128 + p0] = e0_; sel_e[tt * 128 + p1] = e1_;
      sel_w[tt * 128 + p0] = w0_; sel_w[tt * 128 + p1] = w1_;
      if (lane == 0) nlo_tab[tt] = nlo;
    }
    __builtin_amdgcn_wave_barrier();
    {
    const int tidg_ = opaque_vtid();
    const int lane = tidg_ & 63, wave = tidg_ >> 6;
    const int sub = lane & 15, grp = lane >> 4;
#pragma unroll 1
    for (int upass = 0; upass < 2; upass++)
    for (int tt = wave; tt < 32; tt += 4) {
      const long tok = t0 + tt;
      const int ssp = ((nlo_tab[tt] + 8) >> 4) << 1;
      const int s_beg = upass ? ssp : 0, s_end = upass ? 16 : ssp;
      f32x2 xf[32];
      float sx = 0.f;
#pragma unroll
      for (int c = 0; c < 4; c++) {
#pragma unroll
        for (int h2 = 0; h2 < 2; h2++) {
          uint4 xr = *(const uint4*)(p.XB + tok * 1024 + (sub + 16 * c) * 16 + h2 * 8);
          f32x2* xp = xf + c * 8 + h2 * 4;
          xp[0] = f32x2{bflo(xr.x), bfhi(xr.x)}; xp[1] = f32x2{bflo(xr.y), bfhi(xr.y)};
          xp[2] = f32x2{bflo(xr.z), bfhi(xr.z)}; xp[3] = f32x2{bflo(xr.w), bfhi(xr.w)};
        }
      }
#pragma unroll
      for (int i = 0; i < 32; i++) sx += xf[i].x + xf[i].y;
      sx *= 128.f;
      float dk0 = 0.f, dk1 = 0.f;
      u32x4 bufA[8], bufB[8];
#define ISSUE_U(buf, st)                                                                 \
      _Pragma("unroll") for (int j = 0; j < 2; j++) {                                    \
        const int eidx_ = sel_e[tt * 128 + ((st) * 2 + j) * 4 + grp];                    \
        const unsigned char* ur_ = Ul + (long)eidx_ * 1024 + sub * 16;                   \
        _Pragma("unroll") for (int c = 0; c < 4; c++) buf[j * 4 + c] = *(const u32x4*)(ur_ + c * 256); \
      }
#define COMPUTE_U(buf, st)                                                               \
      _Pragma("unroll") for (int j = 0; j < 2; j++) {                                    \
        f32x2 d2 = f32x2{-sx, 0.f};                                                      \
        _Pragma("unroll") for (int c = 0; c < 4; c++)                                    \
          _Pragma("unroll") for (int w = 0; w < 4; w++) {                                \
            const unsigned q = buf[j * 4 + c][w];                                        \
            d2 += f32x2{(float)(q & 0xffu), (float)((q >> 8) & 0xffu)} * xf[c * 8 + w * 2];      \
            d2 += f32x2{(float)((q >> 16) & 0xffu), (float)(q >> 24)} * xf[c * 8 + w * 2 + 1];   \
          }                                                                              \
        float d = d2.x + d2.y;                                                           \
        d += shx<1>(d); d += shx<2>(d); d += shx<4>(d); d += shx<8>(d); \
        const int it_ = (st) * 2 + j;                                                    \
        if (sub == (it_ & 15)) { if (it_ < 16) dk0 = d; else dk1 = d; }                  \
        __builtin_amdgcn_sched_barrier(0);                                               \
      }
      if (s_beg < s_end) { ISSUE_U(bufA, s_beg) }
      for (int st = s_beg; st < s_end; st += 2) {
        ISSUE_U(bufB, st + 1)
        COMPUTE_U(bufA, st)
        if (st + 2 < s_end) { ISSUE_U(bufA, st + 2) }
        COMPUTE_U(bufB, st + 1)
      }
      {
        const int e0 = sub * 4 + grp, e1 = (16 + sub) * 4 + grp;
        const bool in0 = (sub >= 2 * s_beg) && (sub < 2 * s_end), in1 = (16 + sub >= 2 * s_beg) && (16 + sub < 2 * s_end);
        const int x0 = sel_e[tt * 128 + e0], x1 = sel_e[tt * 128 + e1];
        float d0 = dk0 * SUl[x0], d1 = dk1 * SUl[x1];
        float a0 = 0.5f * d0 * (1.f + erff(d0 * 0.7071067811865476f));
        float a1 = 0.5f * d1 * (1.f + erff(d1 * 0.7071067811865476f));
        if (in0) sel_w[tt * 128 + e0] = a0 * sel_w[tt * 128 + e0] * SVl[x0];
        if (in1) sel_w[tt * 128 + e1] = a1 * sel_w[tt * 128 + e1] * SVl[x1];
      }
    }
#pragma unroll 1
    for (int hsel = 0; hsel < 2; hsel++) {
      f32x2 accT[4][8];
      float csumT[4];
#pragma unroll
      for (int ti = 0; ti < 4; ti++) {
        csumT[ti] = 0.f;
#pragma unroll
        for (int i = 0; i < 8; i++) accT[ti][i] = f32x2{0.f, 0.f};
      }
#define ISSUE_V(buf, tt_, st)                                                            \
      _Pragma("unroll") for (int j = 0; j < 8; j++) {                                    \
        const int eidx_ = __builtin_amdgcn_readfirstlane(sel_e[(tt_) * 128 + (st) * 8 + j]); \
        buf[j] = *(const u32x4*)(Vl + (long)eidx_ * 1024 + (unsigned)(lane * 16));       \
      }
#define COMPUTE_V(buf, ti, tt_, st)                                                      \
      _Pragma("unroll") for (int j = 0; j < 8; j++) {                                    \
        const float c_ = sel_w[(tt_) * 128 + (st) * 8 + j];                              \
        csumT[ti] += c_;                                                                 \
        const f32x2 c2 = f32x2{c_, c_};                                                  \
        _Pragma("unroll") for (int w = 0; w < 4; w++) {                                  \
          const unsigned q = buf[j][w];                                                  \
          accT[ti][w * 2] += c2 * f32x2{(float)(q & 0xffu), (float)((q >> 8) & 0xffu)};  \
          accT[ti][w * 2 + 1] += c2 * f32x2{(float)((q >> 16) & 0xffu), (float)(q >> 24)}; \
        }                                                                                \
        if (j & 1) __builtin_amdgcn_sched_barrier(0);                                    \
      }
#pragma unroll 1
      for (int vpass = 0; vpass < 2; vpass++) {
#pragma unroll
        for (int ti = 0; ti < 4; ti++) {
          const int tt = wave + 4 * (hsel * 4 + ti);
          const int ssp = ((nlo_tab[tt] + 8) >> 4) << 1;
          const int c_beg = vpass ? ssp : 0, c_end = vpass ? 16 : ssp;
          u32x4 bufA[8], bufB[8];
          if (c_beg < c_end) { ISSUE_V(bufA, tt, c_beg) }
#pragma unroll 1
          for (int st = c_beg; st < c_end; st += 2) {
            ISSUE_V(bufB, tt, st + 1)
            COMPUTE_V(bufA, ti, tt, st)
            if (st + 2 < c_end) { ISSUE_V(bufA, tt, st + 2) }
            COMPUTE_V(bufB, ti, tt, st + 1)
          }
        }
      }
      peer_finish_token(p, l, last, t0 + wave + 4 * (hsel * 4 + 0), accT[0], csumT[0], lane);
      peer_finish_token(p, l, last, t0 + wave + 4 * (hsel * 4 + 1), accT[1], csumT[1], lane);
      peer_finish_token(p, l, last, t0 + wave + 4 * (hsel * 4 + 2), accT[2], csumT[2], lane);
      peer_finish_token(p, l, last, t0 + wave + 4 * (hsel * 4 + 3), accT[3], csumT[3], lane);
    }
    }
  }
}


#define XB_TMO      128
#define XB_XCNT(j)  (256  + 64 * (j))
#define XB_XSUB(j)  (1280 + 64 * (j))
#define XB_XGEN(j)  (2304 + 64 * (j))
#define XB_TOP      3328
#define XB_TOPGEN   3392
#define XB_CENSUS   3456
#define XB_FFTA     3480
#define XCD_BAR_WORDS 3488
#define XB_SPIN_CAP (1u << 22)
DI unsigned xb_ld(unsigned* p) { return __hip_atomic_load(p, __ATOMIC_RELAXED, __HIP_MEMORY_SCOPE_AGENT); }
DI unsigned xb_add(unsigned* p, unsigned v) { return __hip_atomic_fetch_add(p, v, __ATOMIC_RELAXED, __HIP_MEMORY_SCOPE_AGENT); }
DI unsigned xb_xcc_id() { return (unsigned)__builtin_amdgcn_s_getreg((3 << 11) | 20) & 0xFu; }
#define XB_SPIN(cond, bar) do { unsigned _sp = 0; while (cond) { __builtin_amdgcn_s_sleep(1); \
    if ((++_sp & 255u) == 0u) { if (xb_ld(&(bar)[XB_TMO])) break; if (_sp > XB_SPIN_CAP) { atomicAdd(&(bar)[XB_TMO], 1u); break; } } } } while (0)
struct XcdBarrier { unsigned* bar; unsigned x; volatile LAS unsigned* st; };
DI volatile LAS unsigned* xb_state() { __shared__ uint4 xb_words_; return (volatile LAS unsigned*)&xb_words_; }
DI XcdBarrier xcd_barrier_post(unsigned* bar, volatile LAS unsigned* st) {
  XcdBarrier b; b.bar = bar; b.x = xb_xcc_id(); b.st = st;
  if (threadIdx.x == 0) (void)xb_add(&bar[XB_XCNT(b.x)], 1u);
  return b;
}
DI void xcd_barrier_complete(unsigned* bar, unsigned x, unsigned& nloc, unsigned& nx) {
  const unsigned G = gridDim.x;
  unsigned sum, cnt, mine, sp = 0u;
  for (;;) {
    sum = 0u; cnt = 0u; mine = 0u;
#pragma unroll
    for (unsigned j = 0; j < 16; ++j) { const unsigned c = xb_ld(&bar[XB_XCNT(j)]); sum += c; cnt += (c > 0u) ? 1u : 0u; mine = (j == x) ? c : mine; }
    if (sum == G) break;
    __builtin_amdgcn_s_sleep(1);
    if ((++sp & 255u) == 0u) { if (xb_ld(&bar[XB_TMO])) break; if (sp > XB_SPIN_CAP) { atomicAdd(&bar[XB_TMO], 1u); break; } }
  }
  nloc = mine > 0u ? mine : 1u; nx = cnt > 0u ? cnt : 1u;
}
DI void xcd_barrier(unsigned* bar_, volatile LAS unsigned* st_) {
  XcdBarrier b; b.bar = bar_; b.st = st_; b.x = xb_xcc_id();
  asm volatile("s_waitcnt vmcnt(0)" ::: "memory");
  __syncthreads();
  if (opaque_tid() == 0) {
    unsigned* bar = b.bar;
    __builtin_amdgcn_s_waitcnt(0);
    unsigned nloc = b.st[0], nx = b.st[1];
    if (nloc == 0u) { xcd_barrier_complete(bar, b.x, nloc, nx); b.st[0] = nloc; b.st[1] = nx; }
    const unsigned old = xb_add(&bar[XB_XSUB(b.x)], 1u);
    const unsigned gen = old / nloc;
    if (old + 1u == (gen + 1u) * nloc) {
      __builtin_amdgcn_fence(__ATOMIC_RELEASE, "agent");
      asm volatile("s_waitcnt vmcnt(0)" ::: "memory");
      const unsigned og = xb_add(&bar[XB_TOP], 1u);
      const unsigned tg = og / nx;
      if (og + 1u == (tg + 1u) * nx) xb_add(&bar[XB_TOPGEN], 1u);
      else XB_SPIN(xb_ld(&bar[XB_TOPGEN]) == tg, bar);
      __builtin_amdgcn_fence(__ATOMIC_ACQUIRE, "agent");
      xb_add(&bar[XB_XGEN(b.x)], 1u);
      asm volatile("s_waitcnt vmcnt(0)" ::: "memory");
    } else {
      XB_SPIN(xb_ld(&bar[XB_XGEN(b.x)]) == gen, bar);
      __builtin_amdgcn_fence(__ATOMIC_ACQUIRE, "agent");
      asm volatile("s_waitcnt vmcnt(0)" ::: "memory");
    }
  }
  __syncthreads();
}

#ifndef REP
#define REP -1
#endif
#define BAR() xcd_barrier(p.BAR, xb_state())
#define RUNPH(k, call) do { call; if (REP == (k)) { BAR(); call; } } while (0)
__global__ void __launch_bounds__(NTHR, 2) mega_kernel(P p) {
  extern __shared__ __attribute__((aligned(1024))) char smem[];
  __shared__ int xc_sh[2];
  const int bid = blockIdx.x, nb = gridDim.x;
  if (threadIdx.x == 0) { volatile LAS unsigned* st = xb_state(); st[0] = 0u; st[1] = 0u; st[2] = 0u; st[3] = 0u; }
  if ((threadIdx.x & 63) == 0) wmap()[hw_slot()] = (int)(threadIdx.x >> 6);
  __syncthreads();
  (void)xcd_barrier_post(p.BAR, xb_state());
  if (threadIdx.x == 0) { const unsigned x = xb_xcc_id() & 7u; xc_sh[0] = (int)x; xc_sh[1] = (int)xb_add(&p.BAR[XB_CENSUS + x], 1u); }
  __syncthreads();
  const int vb = __builtin_amdgcn_readfirstlane((int)threadIdx.x >> 8);
  const int vbid = bid * 2 + vb, vnb = nb * 2;
  char* vsmem = smem + vb * VSMEM;
  RUNPH(0, ph_prep(p, vsmem, vbid, vnb));
  BAR();
  Xcd xc;
  xc.id = __builtin_amdgcn_readfirstlane(xc_sh[0]); xc.slot = __builtin_amdgcn_readfirstlane(xc_sh[1]);
  xc.n = __builtin_amdgcn_readfirstlane((int)xb_ld(&p.BAR[XB_CENSUS + xc.id]));
#pragma unroll 1
  for (int l = 0; l < 2; l++) {
    RUNPH(1, ph_inproj(p, l, smem, bid, nb, xc));
    BAR();
    ph_fftA(p, smem, bid, nb);
    {
      asm volatile("s_waitcnt vmcnt(0)" ::: "memory");
      __syncthreads();
      unsigned ndone = 0;
      for (int t2 = bid; t2 < 130; t2 += nb) ndone++;
      if (ndone && opaque_tid() == 0) {
        __builtin_amdgcn_fence(__ATOMIC_RELEASE, "agent");
        asm volatile("s_waitcnt vmcnt(0)" ::: "memory");
        (void)xb_add(&p.BAR[XB_FFTA], ndone);
      }
    }
    RUNPH(2, ph_attn(p, l, vsmem, xc, vb));
    {
      asm volatile("s_waitcnt vmcnt(0)" ::: "memory");
      __syncthreads();
      if (opaque_tid() == 0) {
        const unsigned want = 130u * (unsigned)(l + 1);
        XB_SPIN(xb_ld(&p.BAR[XB_FFTA]) < want, p.BAR);
        __builtin_amdgcn_fence(__ATOMIC_ACQUIRE, "agent");
        asm volatile("s_waitcnt vmcnt(0)" ::: "memory");
      }
      __syncthreads();
    }
    ph_fftC(p, smem, bid, nb);
    BAR();
    RUNPH(4, ph_branch(p, l, smem, bid, nb, xc));
    BAR();
    RUNPH(5, ph_outproj(p, l, smem, bid, nb, xc));
    BAR();
    RUNPH(6, ph_ln1(p, l, vbid, vnb));
    BAR();
    RUNPH(7, ph_peerq(p, l, smem, bid, nb, xc));
    BAR();
    if (REP == 8) { ph_peer(p, l, vsmem, vbid, vnb, true); BAR(); }
    ph_peer(p, l, vsmem, vbid, vnb, l == 1);
    if (l == 0) BAR();
  }
}

extern "C" void kernel_launch(void* const* d_in, const int* in_sizes, int n_in, void* d_out, int out_size,
                              void* d_ws, size_t ws_size, hipStream_t stream) {
  P p{};
  p.x = (const float*)d_in[0]; p.ln0g = (const float*)d_in[1]; p.ln0b = (const float*)d_in[2];
  p.w_in = (const float*)d_in[3]; p.b_gate = (const float*)d_in[4]; p.qng = (const float*)d_in[5]; p.kng = (const float*)d_in[6];
  p.w_bf = (const float*)d_in[7]; p.w_ba = (const float*)d_in[8]; p.w_out = (const float*)d_in[9];
  p.ln1g = (const float*)d_in[10]; p.ln1b = (const float*)d_in[11]; p.w_q = (const float*)d_in[12]; p.sk = (const float*)d_in[13];
  p.pu = (const float*)d_in[14]; p.pv = (const float*)d_in[15]; p.ln2g = (const float*)d_in[16]; p.ln2b = (const float*)d_in[17];
  p.out = (float*)d_out;
  char* w = (char*)d_ws;
  size_t off = 0;
  auto take = [&](size_t bytes) { char* r = w + off; off += (bytes + 255) & ~(size_t)255; return r; };
  p.WIN = (u16*)take((size_t)2 * 3328 * 1024 * 2);
  p.WBF = (u16*)take((size_t)2 * 1024 * 512 * 2);
  p.WBA = (u16*)take((size_t)2 * 1024 * 512 * 2);
  p.WOUT = (u16*)take((size_t)2 * 1024 * 1024 * 2);
  p.WQ = (u16*)take((size_t)2 * 2048 * 1024 * 2);
  p.SK = (u16*)take((size_t)2 * 8 * 2 * 128 * 128 * 2);
  p.U8 = (unsigned char*)take((size_t)2 * 16384 * 1024);
  p.V8 = (unsigned char*)take((size_t)2 * 16384 * 1024);
  p.SU = (float*)take((size_t)2 * 16384 * 4);
  p.SV = (float*)take((size_t)2 * 16384 * 4);
  p.D256 = (u16*)take(256 * 256 * 2);
  p.C64 = (u16*)take(64 * 128 * 2);
  p.TW = (float2*)take(128 * 64 * 8);
  p.ROPE = (float2*)take(128 * 16 * 8);
  p.XS = (float*)take((size_t)T * 1024 * 4);
  p.XB = (u16*)take((size_t)T * 1024 * 2);
  p.ZT = (u16*)take((size_t)33280 * 256 * 2);
  p.GP = (u16*)take((size_t)66560 * 128 * 2);
  p.Y = (u16*)take((size_t)T * 512 * 2);
  p.Q = (u16*)take((size_t)T * 512 * 2);
  p.K = (u16*)take((size_t)T * 128 * 2);
  p.VT = (u16*)take((size_t)T * 128 * 2);
  p.AO = (u16*)take((size_t)T * 512 * 2);
  p.GATES = (u16*)take((size_t)T * 2048 * 2);
  p.QP = p.GATES;
  p.MIXED = (u16*)take((size_t)T * 1024 * 2);
  p.BAR = (unsigned*)take(XCD_BAR_WORDS * 4);
  if (off > ws_size) { fprintf(stderr, "workspace too small: need %zu have %zu\n", off, ws_size); return; }

  static int grid_blocks = 0;
  if (!grid_blocks) {
    int dev = 0, cus = 0, per_cu = 0;
    (void)hipGetDevice(&dev);
    (void)hipDeviceGetAttribute(&cus, hipDeviceAttributeMultiprocessorCount, dev);
    (void)hipFuncSetAttribute((const void*)mega_kernel, hipFuncAttributeMaxDynamicSharedMemorySize, SMEM_BYTES);
    (void)hipOccupancyMaxActiveBlocksPerMultiprocessor(&per_cu, mega_kernel, NTHR, SMEM_BYTES);
    if (per_cu < 1) per_cu = 1;
    grid_blocks = cus;
  }
  (void)hipMemsetAsync(p.BAR, 0, XCD_BAR_WORDS * 4, stream);
  void* args[] = {&p};
  hipError_t e = hipLaunchCooperativeKernel((void*)mega_kernel, dim3(grid_blocks), dim3(NTHR), args, SMEM_BYTES, stream);
  if (e != hipSuccess) fprintf(stderr, "cooperative launch failed: %s (grid %d)\n", hipGetErrorString(e), grid_blocks);
}
```
